# Optimizing an MI355X kernel written in HIP

```python
import jax, jax.numpy as jnp
from jax import lax
import numpy as np

D_MODEL = 2048
BATCH = 4
SEQ = 4096
DEPTH = 2

GRID_W = 64
CTX_LEN = 256
HEAD_DIM = 128
A_HEADS = 6
A_KV = 2
B_HEADS = 4
C_HEADS = 6
C_KV = 2
WINDOW = 128
BLOCK = 128
NA_H = 8
NA_W = 16
ROPE_THETA = 10000.0
D_FF = 5632
CONV_W = 3
N_BRANCH = 3
EPS = 1e-6
NEG = -1e30
A_WIDTH = A_HEADS * HEAD_DIM
B_WIDTH = B_HEADS * HEAD_DIM
C_WIDTH = C_HEADS * HEAD_DIM
MIX_WIDTH = A_WIDTH + B_WIDTH + C_WIDTH
IN_SIZES = (A_HEADS * HEAD_DIM, A_KV * HEAD_DIM, A_KV * HEAD_DIM,
            B_HEADS * HEAD_DIM, B_HEADS * HEAD_DIM, B_HEADS * HEAD_DIM,
            C_HEADS * HEAD_DIM, C_KV * HEAD_DIM, C_KV * HEAD_DIM,
            N_BRANCH * D_MODEL)
IN_COLS = sum(IN_SIZES)

kernel_name = "hybrid_dit_parallel_gated_mixers"


def rmsnorm(x, g):
    x32 = x.astype(jnp.float32)
    y = x32 * lax.rsqrt(jnp.mean(x32 * x32, axis=-1, keepdims=True) + EPS)
    return (y * g.astype(jnp.float32)).astype(x.dtype)


def modulate(xn, shift, scale):
    return xn * (1 + scale) + shift


def axial_angles(n):
    t = jnp.arange(n)
    row = (t // GRID_W).astype(jnp.float32)
    col = (t % GRID_W).astype(jnp.float32)
    quarter = HEAD_DIM // 4
    inv = ROPE_THETA ** (-jnp.arange(quarter, dtype=jnp.float32) / quarter)
    ang_r = row[:, None] * inv[None, :]
    ang_c = col[:, None] * inv[None, :]
    return (jnp.cos(ang_r), jnp.sin(ang_r), jnp.cos(ang_c), jnp.sin(ang_c))


def rotate_half(x, cos, sin):
    m = x.shape[-1] // 2
    x1, x2 = x[..., :m], x[..., m:]
    cos, sin = cos[:, None, :], sin[:, None, :]
    return jnp.concatenate([x1 * cos - x2 * sin, x2 * cos + x1 * sin], axis=-1)


def axial_rope(x, rope):
    cr, sr, cc, sc = rope
    half = HEAD_DIM // 2
    out = jnp.concatenate([rotate_half(x[..., :half], cr, sr),
                           rotate_half(x[..., half:], cc, sc)], axis=-1)
    return out.astype(x.dtype)


def softmax_with_sink(s, sink):
    sink = jnp.broadcast_to(sink.astype(jnp.float32), s.shape[:-1] + (1,))
    m = jnp.maximum(jnp.max(s, axis=-1, keepdims=True), sink)
    e = jnp.exp(s - m)
    return e / (jnp.sum(e, axis=-1, keepdims=True) + jnp.exp(sink - m))


def project(h, w_in):
    parts = jnp.split(h @ w_in, np.cumsum(IN_SIZES)[:-1].tolist(), axis=-1)
    counts = (A_HEADS, A_KV, A_KV, B_HEADS, B_HEADS, B_HEADS, C_HEADS, C_KV, C_KV)
    qkv = [t.reshape(t.shape[:-1] + (n, HEAD_DIM)) for t, n in zip(parts[:-1], counts)]
    return (*qkv, parts[-1])


def dense_ctx_attention(q, k, v, sink=None):
    b, n, h, d = q.shape
    kv = k.shape[2]
    qg = q.reshape(b, n, kv, h // kv, d)
    s = jnp.einsum('bqkgd,bskd->bkgqs', qg, k).astype(jnp.float32) * d ** -0.5
    if sink is None:
        p = jax.nn.softmax(s, axis=-1)
    else:
        p = softmax_with_sink(s, sink.reshape(1, kv, h // kv, 1, 1))
    o = jnp.einsum('bkgqs,bskd->bqkgd', p.astype(v.dtype), v)
    return o.reshape(b, n, h * d)


def windowed_attention(q, k, v, k_ctx, v_ctx, sink):
    b, s, h, d = q.shape
    kv = k.shape[2]
    g = h // kv
    nb = s // BLOCK
    qb = q.reshape(b, nb, BLOCK, kv, g, d)

    def band(t):
        tp = jnp.pad(t, ((0, 0), (BLOCK, BLOCK), (0, 0), (0, 0))).reshape(b, nb + 2, BLOCK, kv, d)
        return jnp.concatenate([tp[:, :-2], tp[:, 1:-1], tp[:, 2:]], axis=2)

    kb, vb = band(k), band(v)
    scale = d ** -0.5
    s_lat = jnp.einsum('bnqkgd,bnskd->bnkgqs', qb, kb).astype(jnp.float32) * scale
    q_pos = jnp.arange(nb)[:, None] * BLOCK + jnp.arange(BLOCK)[None, :]
    k_pos = (jnp.arange(nb)[:, None] - 1) * BLOCK + jnp.arange(3 * BLOCK)[None, :]
    kp = k_pos[:, None, :]
    valid = (kp >= 0) & (kp < s) & (jnp.abs(kp - q_pos[:, :, None]) <= WINDOW)
    s_lat = jnp.where(valid[None, :, None, None], s_lat, NEG)
    s_ctx = jnp.einsum('bnqkgd,bckd->bnkgqc', qb, k_ctx).astype(jnp.float32) * scale
    p = softmax_with_sink(jnp.concatenate([s_lat, s_ctx], axis=-1),
                          sink.reshape(1, 1, kv, g, 1, 1)).astype(v.dtype)
    o = (jnp.einsum('bnkgqs,bnskd->bnqkgd', p[..., :3 * BLOCK], vb)
         + jnp.einsum('bnkgqc,bckd->bnqkgd', p[..., 3 * BLOCK:], v_ctx))
    return o.reshape(b, s, h * d)


def neighbourhood_attention(q, k, v, k_ctx, v_ctx, rpb):
    b, s, h, d = q.shape
    rows = s // GRID_W
    kh = min(NA_H, rows)
    kw = NA_W
    scale = d ** -0.5
    qg = jnp.moveaxis(q.reshape(b, rows, GRID_W, h, d), 1, 0)
    kg = k.reshape(b, rows, GRID_W, h, d)
    vg = v.reshape(b, rows, GRID_W, h, d)
    cols = jnp.arange(GRID_W)
    cs = jnp.clip(cols - kw // 2, 0, GRID_W - kw)
    col_valid = (cols[None, :] >= cs[:, None]) & (cols[None, :] < cs[:, None] + kw)
    mask = jnp.tile(col_valid, (1, kh))
    dc = jnp.clip(cols[None, :] - cols[:, None] + NA_W - 1, 0, 2 * NA_W - 2)

    def row_block(args):
        q_row, r = args
        rs = jnp.clip(r - kh // 2, 0, rows - kh)
        k_strip = lax.dynamic_slice_in_dim(kg, rs, kh, axis=1).reshape(b, kh * GRID_W, h, d)
        v_strip = lax.dynamic_slice_in_dim(vg, rs, kh, axis=1).reshape(b, kh * GRID_W, h, d)
        dr = rs + jnp.arange(kh) - r + NA_H - 1
        bias = rpb[:, dr][:, :, dc]
        bias = jnp.transpose(bias, (0, 2, 1, 3)).reshape(h, GRID_W, kh * GRID_W)
        s_lat = jnp.einsum('bqhd,bshd->bhqs', q_row, k_strip).astype(jnp.float32) * scale
        s_lat = jnp.where(mask, s_lat + bias.astype(jnp.float32), NEG)
        s_ctx = jnp.einsum('bqhd,bchd->bhqc', q_row, k_ctx).astype(jnp.float32) * scale
        p = jax.nn.softmax(jnp.concatenate([s_lat, s_ctx], axis=-1), axis=-1).astype(v.dtype)
        return (jnp.einsum('bhqs,bshd->bqhd', p[..., :kh * GRID_W], v_strip)
                + jnp.einsum('bhqc,bchd->bqhd', p[..., kh * GRID_W:], v_ctx))

    o = lax.map(row_block, (qg, jnp.arange(rows)))
    return jnp.moveaxis(o, 0, 1).reshape(b, s, h * d)


def global_attention(q, k, v, k_ctx, v_ctx):
    b, s, h, d = q.shape
    kv = k.shape[2]
    g = h // kv
    nb = s // BLOCK
    k_all = jnp.concatenate([k_ctx, k], axis=1)
    v_all = jnp.concatenate([v_ctx, v], axis=1)
    qb = jnp.moveaxis(q.reshape(b, nb, BLOCK, kv, g, d), 1, 0)
    scale = d ** -0.5

    def block(qi):
        sc = jnp.einsum('bqkgd,bskd->bkgqs', qi, k_all).astype(jnp.float32) * scale
        p = jax.nn.softmax(sc, axis=-1).astype(v.dtype)
        return jnp.einsum('bkgqs,bskd->bqkgd', p, v_all)

    o = lax.map(block, qb)
    return jnp.moveaxis(o, 0, 1).reshape(b, s, h * d)


def merge_branches(o_a, o_b, o_c, gates, w_branch, w_out):
    ga, gb, gc = jnp.split(jax.nn.sigmoid(gates), N_BRANCH, axis=-1)
    br_a = o_a @ w_branch[:A_WIDTH]
    br_b = o_b @ w_branch[A_WIDTH:A_WIDTH + B_WIDTH]
    br_c = o_c @ w_branch[A_WIDTH + B_WIDTH:]
    return (ga * br_a + gb * br_b + gc * br_c) @ w_out


def conv_ffn(h, w_up, conv_w, conv_b, w_down):
    a, u = jnp.split(h @ w_up, 2, axis=-1)
    n = a.shape[1]
    pad = CONV_W // 2
    ap = jnp.pad(a, ((0, 0), (pad, pad), (0, 0)))
    a = sum(ap[:, i:i + n] * conv_w[i] for i in range(CONV_W)) + conv_b
    return (jax.nn.silu(a) * u) @ w_down


def setup_inputs(seed: int = 0) -> dict:
    key = jax.random.key(seed)
    ks = jax.random.split(key, 20)
    D = D_MODEL

    def nrm(k, shape, scale):
        return jax.random.normal(k, shape, jnp.float32) * scale

    return {
        "x": nrm(ks[0], (BATCH, SEQ, D), 1.0),
        "c": nrm(ks[1], (BATCH, D), 1.0),
        "ctx": nrm(ks[2], (BATCH, CTX_LEN, D), 1.0),
        "c_ctx": nrm(ks[3], (D,), 1.0),
        "w_ada": nrm(ks[4], (DEPTH, D, 6 * D), 0.5 * D ** -0.5),
        "b_ada": nrm(ks[5], (DEPTH, 6 * D), 0.01),
        "norm1": 1.0 + nrm(ks[6], (DEPTH, D), 0.05),
        "w_in": nrm(ks[7], (DEPTH, D, IN_COLS), D ** -0.5),
        "sink_a": nrm(ks[8], (DEPTH, A_HEADS), 0.5),
        "rpb_b": nrm(ks[9], (DEPTH, B_HEADS, 2 * NA_H - 1, 2 * NA_W - 1), 0.5),
        "qnorm_c": 1.0 + nrm(ks[10], (DEPTH, HEAD_DIM), 0.05),
        "knorm_c": 1.0 + nrm(ks[11], (DEPTH, HEAD_DIM), 0.05),
        "w_branch": nrm(ks[12], (DEPTH, MIX_WIDTH, D), B_WIDTH ** -0.5),
        "w_out": nrm(ks[13], (DEPTH, D, D), D ** -0.5),
        "norm2": 1.0 + nrm(ks[14], (DEPTH, D), 0.05),
        "w_up": nrm(ks[15], (DEPTH, D, 2 * D_FF), D ** -0.5),
        "conv_w": nrm(ks[16], (DEPTH, CONV_W, D_FF), CONV_W ** -0.5),
        "conv_b": nrm(ks[17], (DEPTH, D_FF), 0.01),
        "w_down": nrm(ks[18], (DEPTH, D_FF, D), D_FF ** -0.5),
        "final_norm": 1.0 + nrm(ks[19], (D,), 0.05),
    }


def reference(x, c, ctx, c_ctx, w_ada, b_ada, norm1, w_in, sink_a, rpb_b, qnorm_c, knorm_c,
              w_branch, w_out, norm2, w_up, conv_w, conv_b, w_down, final_norm):
    rope = axial_angles(x.shape[1])
    xc = ctx
    silu_c = jax.nn.silu(c)
    silu_cc = jax.nn.silu(c_ctx)
    for l in range(DEPTH):
        last = l == DEPTH - 1
        mod = jnp.split((silu_c @ w_ada[l] + b_ada[l])[:, None, :], 6, axis=-1)
        mod_c = jnp.split(silu_cc @ w_ada[l] + b_ada[l], 6, axis=-1)

        h = modulate(rmsnorm(x, norm1[l]), mod[0], mod[1])
        hc = modulate(rmsnorm(xc, norm1[l]), mod_c[0], mod_c[1])
        qa, ka, va, qb, kb, vb, qc, kc, vc, gates = project(h, w_in[l])
        qa_x, ka_x, va_x, qb_x, kb_x, vb_x, qc_x, kc_x, vc_x, gates_x = project(hc, w_in[l])
        qc = rmsnorm(qc, qnorm_c[l])
        kc = rmsnorm(kc, knorm_c[l])
        kc_x = rmsnorm(kc_x, knorm_c[l])

        o_a = windowed_attention(axial_rope(qa, rope), axial_rope(ka, rope), va, ka_x, va_x, sink_a[l])
        o_b = neighbourhood_attention(qb, kb, vb, kb_x, vb_x, rpb_b[l])
        o_c = global_attention(axial_rope(qc, rope), axial_rope(kc, rope), vc, kc_x, vc_x)
        x = x + mod[2] * merge_branches(o_a, o_b, o_c, gates, w_branch[l], w_out[l])

        h2 = modulate(rmsnorm(x, norm2[l]), mod[3], mod[4])
        x = x + mod[5] * conv_ffn(h2, w_up[l], conv_w[l], conv_b[l], w_down[l])

        if not last:
            oa_x = dense_ctx_attention(qa_x, ka_x, va_x, sink_a[l])
            ob_x = dense_ctx_attention(qb_x, kb_x, vb_x)
            oc_x = dense_ctx_attention(rmsnorm(qc_x, qnorm_c[l]), kc_x, vc_x)
            xc = xc + mod_c[2] * merge_branches(oa_x, ob_x, oc_x, gates_x, w_branch[l], w_out[l])
            hc2 = modulate(rmsnorm(xc, norm2[l]), mod_c[3], mod_c[4])
            xc = xc + mod_c[5] * conv_ffn(hc2, w_up[l], conv_w[l], conv_b[l], w_down[l])
    return rmsnorm(x, final_norm)
```

```cpp
#include <hip/hip_runtime.h>
#include <hip/hip_cooperative_groups.h>
#include <cstdio>
#include <cstdint>
namespace cg = cooperative_groups;

#ifndef MK_COOP
#define MK_COOP 1
#endif

#define LAS __attribute__((address_space(3)))
typedef unsigned short bf16_t;
typedef short bf16x8 __attribute__((ext_vector_type(8)));
typedef short s16x4 __attribute__((ext_vector_type(4)));
typedef float f32x4 __attribute__((ext_vector_type(4)));
typedef float f32x16 __attribute__((ext_vector_type(16)));
typedef unsigned u32x4 __attribute__((ext_vector_type(4)));
typedef unsigned u32x2 __attribute__((ext_vector_type(2)));
typedef int i32x4 __attribute__((ext_vector_type(4)));
#ifndef UP_I8_MASK
#define UP_I8_MASK 1
#endif

constexpr int DM = 2048, NBATCH = 4, SEQ = 4096, CTXL = 256, DEPTH = 2;
constexpr int MLAT = NBATCH * SEQ, MCTX = NBATCH * CTXL, MTOT = MLAT + MCTX;
constexpr int NQ = 10240, DFF = 5632, NUP = 2 * DFF;
constexpr int QP = 4096;
constexpr int QA = 0, KA = 768, VA = 1024, QB = 1280, KB = 1792, VB = 2304, QC = 2816, KC = 3584, VC = 3840, GA = 4096, GB = 6144, GC = 8192;
constexpr int OA = 0, OB = 768, OC = 1280;
constexpr float EPS = 1e-6f;
constexpr int NTHREADS = 512;
constexpr int LDS_MISC = 131072, LDS_BYTES = 131072 + 2048;

constexpr size_t al256(size_t x) { return (x + 255) / 256 * 256; }
constexpr size_t WS_CTL = 0;
constexpr size_t WS_BAR = 4096;
constexpr size_t WS_CTL_BYTES = 4096 + 16384;
constexpr size_t WS_MOD = WS_CTL_BYTES;
constexpr size_t WS_XC = al256(WS_MOD + (size_t)DEPTH * 5 * 6 * DM * 4);
constexpr size_t WS_WT = al256(WS_XC + (size_t)MCTX * DM * 4);
constexpr size_t WT_IN = 0, WT_BR = WT_IN + (size_t)NQ * DM, WT_OUT = WT_BR + (size_t)DM * DM, WT_UP = WT_OUT + (size_t)DM * DM, WT_DOWN = WT_UP + (size_t)NUP * DM, WT_END = WT_DOWN + (size_t)DM * DFF;
constexpr size_t WS_R1 = al256(WS_WT + WT_END * 2);
constexpr size_t WS_GATES = WS_R1 + (size_t)MTOT * QP * 2;
constexpr size_t WS_B = al256(WS_R1 + (size_t)MTOT * NQ * 2);
constexpr size_t BUF1 = (size_t)MTOT * DM * 2;
constexpr size_t EDGE_N = (size_t)(MTOT / 64) * 2 * DFF;
constexpr size_t WS_EDGE = WS_B + BUF1;
static_assert(3 * EDGE_N * 4 <= 2 * BUF1, "edge buffers must fit B2+B3");
constexpr size_t WS_PART = al256(WS_B + 3 * BUF1);
constexpr size_t WS_W8IN = al256(WS_PART + (size_t)8 * MCTX * DM * 4);
constexpr size_t WS_W8UP = al256(WS_W8IN + (size_t)NQ * DM);
constexpr size_t WS_CSIN = al256(WS_W8UP + (size_t)NUP * DM);
constexpr size_t WS_CSUP = al256(WS_CSIN + (size_t)NQ * 4);
constexpr size_t WS_RS = al256(WS_CSUP + (size_t)NUP * 4);
constexpr size_t WS_END = WS_RS + (size_t)MTOT * 4;

struct Params {
    const float *x, *c, *ctx, *c_ctx, *w_ada, *b_ada, *norm1, *w_in, *sink_a, *rpb_b, *qnorm_c, *knorm_c, *w_branch, *w_out, *norm2, *w_up, *conv_w, *conv_b, *w_down, *final_norm;
    float* out; unsigned char* ws;
    int ph_lo, ph_hi, coop, pad;
};

__device__ __forceinline__ unsigned cvt_pk_bf16(float lo, float hi) { unsigned r; asm volatile("v_cvt_pk_bf16_f32 %0, %1, %2" : "=v"(r) : "v"(lo), "v"(hi)); return r; }
__device__ __forceinline__ float bf_lo(unsigned w) { return __uint_as_float(w << 16); }
__device__ __forceinline__ float bf_hi(unsigned w) { return __uint_as_float(w & 0xffff0000u); }
__device__ __forceinline__ int opaque_tid() { int t = threadIdx.x; asm volatile("" : "+v"(t)); return t; }
template <int X> __device__ __forceinline__ float xor_swz(float v) { return __int_as_float(__builtin_amdgcn_ds_swizzle(__float_as_int(v), (X << 10) | 0x1f)); }
__device__ __forceinline__ float wave_max(float v) {
    v = fmaxf(v, xor_swz<1>(v)); v = fmaxf(v, xor_swz<2>(v)); v = fmaxf(v, xor_swz<4>(v)); v = fmaxf(v, xor_swz<8>(v)); v = fmaxf(v, xor_swz<16>(v));
    auto rr = __builtin_amdgcn_permlane32_swap(__float_as_uint(v), __float_as_uint(v), false, false);
    return fmaxf(__uint_as_float(rr[0]), __uint_as_float(rr[1]));
}
__device__ __forceinline__ unsigned pack_i8x4(float a, float b, float c, float d) {
    const int ia = __float2int_rn(a), ib = __float2int_rn(b), ic = __float2int_rn(c), id = __float2int_rn(d);
    return (unsigned)(ia & 0xff) | ((unsigned)(ib & 0xff) << 8) | ((unsigned)(ic & 0xff) << 16) | ((unsigned)id << 24);
}
__device__ __forceinline__ float wave_sum(float v) {
    v += xor_swz<1>(v); v += xor_swz<2>(v); v += xor_swz<4>(v); v += xor_swz<8>(v); v += xor_swz<16>(v);
    auto rr = __builtin_amdgcn_permlane32_swap(__float_as_uint(v), __float_as_uint(v), false, false);
    return __uint_as_float(rr[0]) + __uint_as_float(rr[1]);
}

namespace pg8 {
#ifndef PG8_WGM
#define PG8_WGM 4
#endif
#ifndef PG8_WGM_WIDE
#define PG8_WGM_WIDE 8
#endif
constexpr int BM = 256, BK = 64, HALF = 128, HTB = HALF * BK * 2, STAGE_BYTES = 8 * HTB, NXCD = 8, WGM = PG8_WGM;
__device__ __forceinline__ int lds_byte(int r, int c) { const int st = (r >> 4) * 2 + (c >> 5), rr = r & 15, cc = c & 31, ob = rr * 64 + cc * 2; return st * 1024 + (ob ^ (((ob >> 9) & 1) << 5)); }
__device__ __forceinline__ void stage_rc(int b, int& R, int& C) { const int st = b / 1024, sb = b % 1024, swz = sb ^ (((sb >> 9) & 1) << 5); R = (st >> 1) * 16 + swz / 64; C = (st & 1) * 32 + (swz % 64) / 2; }
__device__ __forceinline__ int perm32(int rho) { const int n = rho >> 4, i = rho & 15; return 8 * (i >> 2) + 4 * n + (i & 3); }
struct Unit { int pm, pn, seg, k0, ntk, split, sl; };
struct Gemm { const void* A; const void* Bt; int M, N, PB; };
struct StaticOrder {
    int nM, nN, nwg, G, c, nMs, ntK, wgm;
    __device__ void init(int M, int N, int PB, int G_, int c_, int nMs_) { nM = M / BM - nMs_; nN = N / BM; nwg = nM * nN; G = G_; c = c_; nMs = nMs_; ntK = PB / 128; wgm = nN > 8 ? PG8_WGM_WIDE : WGM; }
    template <int SEGN> __device__ bool next(int i, Unit& u) const {
        if (SEGN > 1) { u.seg = i % SEGN; i /= SEGN; u.k0 = u.seg == 0 ? 0 : (u.seg == 1 ? 12 : 20); u.ntk = u.seg == 1 ? 8 : 12; }
        else { u.seg = 0; u.k0 = 0; u.ntk = ntK; }
        u.split = 0; u.sl = 0;
        const long L = (long)i * G + c;
        if (L < nwg) {
            int wgid = (int)L; { const int q = nwg / NXCD, r = nwg % NXCD, xcd = wgid % NXCD, off = wgid / NXCD; wgid = (xcd < r ? xcd * (q + 1) : r * (q + 1) + (xcd - r) * q) + off; }
            const int nig = wgm * nN, gid = wgid / nig, fm = gid * wgm, gsz = (nM - fm) < wgm ? (nM - fm) : wgm;
            u.pm = fm + ((wgid % nig) % gsz); u.pn = (wgid % nig) / gsz; return true;
        }
        if (SEGN > 1 || nMs == 0) return false;
        const long first = ((long)nwg + G - 1) / G * G;
        if (L < first) return false;
        const int sub = (int)(L - first), tile = sub >> 3, sl = sub & 7;
        if (tile >= nMs * nN) return false;
        u.pm = nM + tile / nN; u.pn = tile % nN; u.split = 1; u.sl = sl;
        const int pairs = ntK >> 1, base = pairs >> 3, rem = pairs & 7;
        u.ntk = 2 * (base + (sl < rem ? 1 : 0)); u.k0 = 2 * (sl * base + (sl < rem ? sl : rem));
        return true;
    }
};

struct EpiStore {
    static constexpr bool PERM = true; static constexpr int SEGN = 1;
    bf16_t* O; int ldc; int dry;
    __device__ __forceinline__ void operator()(f32x4 (&acc)[2][2][4][2], const Unit& u, int wr, int wc, int fr, int fq) const {
        if (dry) return;
        const int row0 = u.pm * BM + wr * 64 + fr, col0 = u.pn * BM + wc * 32 + 8 * fq;
#pragma unroll
        for (int ai = 0; ai < 2; ++ai)
#pragma unroll
            for (int m = 0; m < 4; ++m) { bf16_t* rowp = O + (size_t)(row0 + ai * HALF + m * 16) * ldc + col0;
#pragma unroll
                for (int bj = 0; bj < 2; ++bj) { const f32x4 v0 = acc[ai][bj][m][0], v1 = acc[ai][bj][m][1];
                    u32x4 w; w.x = cvt_pk_bf16(v0[0], v0[1]); w.y = cvt_pk_bf16(v0[2], v0[3]); w.z = cvt_pk_bf16(v1[0], v1[1]); w.w = cvt_pk_bf16(v1[2], v1[3]);
                    *(u32x4*)(rowp + bj * HALF) = w; } }
    }
};
struct EpiStoreQ {
    static constexpr bool PERM = true; static constexpr int SEGN = 1;
    bf16_t* O; int ldc; const float* rs; const float* cs; unsigned char* gt;
    __device__ __forceinline__ void operator()(f32x4 (&acc)[2][2][4][2], const Unit& u, int wr, int wc, int fr, int fq) const {
        const int row0 = u.pm * BM + wr * 64 + fr, col0 = u.pn * BM + wc * 32 + 8 * fq;
        const bool gate_tile = u.pn >= QP / BM;
        unsigned char* gbase = gt + ((size_t)((((u.pn - QP / BM) >> 3) * (MTOT / BM) + u.pm) * 8 + ((u.pn - QP / BM) & 7)) << 17) + (size_t)((((wr * 4 + wc) << 6) + fq * 16 + fr) * 16);
        f32x4 cv[2][2];
#pragma unroll
        for (int bj = 0; bj < 2; ++bj)
#pragma unroll
            for (int n = 0; n < 2; ++n) cv[bj][n] = *(const f32x4*)(cs + col0 + bj * HALF + 4 * n);
#pragma unroll
        for (int ai = 0; ai < 2; ++ai)
#pragma unroll
            for (int m = 0; m < 4; ++m) { const int row = row0 + ai * HALF + m * 16; const float r = rs[row]; bf16_t* rowp = O + (size_t)row * ldc + col0;
#pragma unroll
                for (int bj = 0; bj < 2; ++bj) { const i32x4 i0 = __builtin_bit_cast(i32x4, acc[ai][bj][m][0]), i1 = __builtin_bit_cast(i32x4, acc[ai][bj][m][1]);
                    float v[8];
#pragma unroll
                    for (int j = 0; j < 4; ++j) { v[j] = (float)i0[j] * r * cv[bj][0][j]; v[4 + j] = (float)i1[j] * r * cv[bj][1][j]; }
                    u32x4 w; w.x = cvt_pk_bf16(v[0], v[1]); w.y = cvt_pk_bf16(v[2], v[3]); w.z = cvt_pk_bf16(v[4], v[5]); w.w = cvt_pk_bf16(v[6], v[7]);
                    if (gate_tile) *(u32x4*)(gbase + ((ai * 2 + bj) * 4 + m) * 8192) = w;
                    else *(u32x4*)(rowp + bj * HALF) = w; } }
    }
};
struct EpiResid {
    static constexpr bool PERM = false; static constexpr int SEGN = 1;
    float* xlat; float* xctx; const float* slat; const float* sctx; const float* modv; float* part; int dry;
    __device__ __forceinline__ void operator()(f32x4 (&acc)[2][2][4][2], const Unit& u, int wr, int wc, int fr, int fq) const {
        if (dry) return;
        const int set = u.pm < (MLAT / BM) ? (u.pm >> 4) : 4;
        float* xb = u.pm < (MLAT / BM) ? xlat + (size_t)u.pm * BM * DM : xctx + (size_t)(u.pm - MLAT / BM) * BM * DM;
        const float* sb = u.pm < (MLAT / BM) ? slat + (size_t)u.pm * BM * DM : sctx + (size_t)(u.pm - MLAT / BM) * BM * DM;
        float* pp = part + ((size_t)u.sl * MCTX + (size_t)(u.pm - MLAT / BM) * BM) * DM;
        const int col0 = u.pn * BM + wc * 32 + 4 * fq;
        const float* mp = modv + (size_t)set * 6 * DM + col0;
        f32x4 mv[2][2];
#pragma unroll
        for (int bj = 0; bj < 2; ++bj)
#pragma unroll
            for (int n = 0; n < 2; ++n) mv[bj][n] = *(const f32x4*)(mp + bj * HALF + n * 16);
        if (u.split) {
#pragma unroll
            for (int ai = 0; ai < 2; ++ai)
#pragma unroll
                for (int m = 0; m < 4; ++m) { const size_t ro = (size_t)(ai * HALF + wr * 64 + m * 16 + fr) * DM + col0;
#pragma unroll
                    for (int bj = 0; bj < 2; ++bj)
#pragma unroll
                        for (int n = 0; n < 2; ++n) *(f32x4*)(pp + ro + bj * HALF + n * 16) = mv[bj][n] * acc[ai][bj][m][n]; }
            return;
        }
#pragma unroll
        for (int ai = 0; ai < 2; ++ai) {
            f32x4 xv[4][2][2];
#pragma unroll
            for (int m = 0; m < 4; ++m) { const float* srcp = sb + (size_t)(ai * HALF + wr * 64 + m * 16 + fr) * DM + col0;
#pragma unroll
                for (int bj = 0; bj < 2; ++bj)
#pragma unroll
                    for (int n = 0; n < 2; ++n) xv[m][bj][n] = *(const f32x4*)(srcp + bj * HALF + n * 16); }
#pragma unroll
            for (int m = 0; m < 4; ++m) { float* rowp = xb + (size_t)(ai * HALF + wr * 64 + m * 16 + fr) * DM + col0;
#pragma unroll
                for (int bj = 0; bj < 2; ++bj)
#pragma unroll
                    for (int n = 0; n < 2; ++n) *(f32x4*)(rowp + bj * HALF + n * 16) = xv[m][bj][n] + mv[bj][n] * acc[ai][bj][m][n]; }
            asm volatile("" ::: "memory"); }
    }
};
struct EpiBranch {
    static constexpr bool PERM = true; static constexpr int SEGN = 3;
    const unsigned char* gt; bf16_t* O; int dry;
    __device__ __forceinline__ const unsigned char* gtile(int g, const Unit& u, int wr, int wc, int fr, int fq) const { return gt + ((size_t)((g * (MTOT / BM) + u.pm) * 8 + u.pn) << 17) + (size_t)((((wr * 4 + wc) << 6) + fq * 16 + fr) * 16); }
    __device__ __forceinline__ void rescale(f32x4 (&acc)[2][2][4][2], const Unit& u, int which, int wr, int wc, int fr, int fq) const {
        const unsigned char* p1 = gtile(which, u, wr, wc, fr, fq); const unsigned char* p2 = gtile(which + 1, u, wr, wc, fr, fq);
#pragma unroll
        for (int ai = 0; ai < 2; ++ai) {
            u32x4 g1v[4][2], g2v[4][2];
#pragma unroll
            for (int m = 0; m < 4; ++m) {
#pragma unroll
                for (int bj = 0; bj < 2; ++bj) { g1v[m][bj] = *(const u32x4*)(p1 + ((ai * 2 + bj) * 4 + m) * 8192); g2v[m][bj] = *(const u32x4*)(p2 + ((ai * 2 + bj) * 4 + m) * 8192); } }
#pragma unroll
            for (int m = 0; m < 4; ++m) {
#pragma unroll
                for (int bj = 0; bj < 2; ++bj) { const u32x4 g1 = g1v[m][bj], g2 = g2v[m][bj];
#pragma unroll
                    for (int q = 0; q < 4; ++q) { const float a0 = bf_lo(g1[q]), a1 = bf_hi(g1[q]), b0 = bf_lo(g2[q]), b1 = bf_hi(g2[q]);
                        const float r0 = (1.f + __expf(-b0)) * __builtin_amdgcn_rcpf(1.f + __expf(-a0)), r1 = (1.f + __expf(-b1)) * __builtin_amdgcn_rcpf(1.f + __expf(-a1));
                        acc[ai][bj][m][q >> 1][(q & 1) * 2] *= r0; acc[ai][bj][m][q >> 1][(q & 1) * 2 + 1] *= r1; } } }
            asm volatile("" ::: "memory"); }
    }
    __device__ __forceinline__ void operator()(f32x4 (&acc)[2][2][4][2], const Unit& u, int wr, int wc, int fr, int fq) const {
        if (dry) return;
        if (u.seg < 2) { rescale(acc, u, u.seg, wr, wc, fr, fq); return; }
        const int row0 = u.pm * BM + wr * 64 + fr, col0 = u.pn * BM + wc * 32 + 8 * fq;
        const unsigned char* p3 = gtile(2, u, wr, wc, fr, fq);
#pragma unroll
        for (int ai = 0; ai < 2; ++ai) {
            u32x4 gv[4][2];
#pragma unroll
            for (int m = 0; m < 4; ++m) {
#pragma unroll
                for (int bj = 0; bj < 2; ++bj) gv[m][bj] = *(const u32x4*)(p3 + ((ai * 2 + bj) * 4 + m) * 8192); }
#pragma unroll
            for (int m = 0; m < 4; ++m) { bf16_t* rowp = O + (size_t)(row0 + ai * HALF + m * 16) * DM + col0;
#pragma unroll
                for (int bj = 0; bj < 2; ++bj) { const u32x4 g = gv[m][bj]; float v[8];
#pragma unroll
                    for (int q = 0; q < 4; ++q) { const float s0 = __builtin_amdgcn_rcpf(1.f + __expf(-bf_lo(g[q]))), s1 = __builtin_amdgcn_rcpf(1.f + __expf(-bf_hi(g[q])));
                        v[2 * q] = acc[ai][bj][m][q >> 1][(q & 1) * 2] * s0; v[2 * q + 1] = acc[ai][bj][m][q >> 1][(q & 1) * 2 + 1] * s1; }
                    u32x4 w; w.x = cvt_pk_bf16(v[0], v[1]); w.y = cvt_pk_bf16(v[2], v[3]); w.z = cvt_pk_bf16(v[4], v[5]); w.w = cvt_pk_bf16(v[6], v[7]);
                    *(u32x4*)(rowp + bj * HALF) = w; } }
            asm volatile("" ::: "memory"); }
    }
};

template <int CTRL> __device__ __forceinline__ float dppf(float x) { return __int_as_float(__builtin_amdgcn_update_dpp(0, __float_as_int(x), CTRL, 0xf, 0xf, false)); }
template <bool Q> struct EpiGLU {
    static constexpr bool PERM = true; static constexpr int SEGN = 1;
    bf16_t* G; const float* cw; const float* cb; float* ES; float* EA; float* EU; int dry; const float* rs; const float* cs;
    __device__ __forceinline__ void operator()(f32x4 (&acc)[2][2][4][2], const Unit& u, int wr, int wc, int fr, int fq) const {
        if (dry) return;
        const int colg = u.pn * 128 + wc * 32 + 8 * fq;
        if constexpr (Q) {
            const int ct = u.pn * BM + wc * 32 + 8 * fq;
            f32x4 cv[2][2];
#pragma unroll
            for (int bj = 0; bj < 2; ++bj)
#pragma unroll
                for (int n = 0; n < 2; ++n) cv[bj][n] = *(const f32x4*)(cs + ct + bj * HALF + 4 * n);
#pragma unroll
            for (int ai = 0; ai < 2; ++ai)
#pragma unroll
                for (int m = 0; m < 4; ++m) { const float r = rs[u.pm * BM + ai * HALF + wr * 64 + m * 16 + fr];
#pragma unroll
                    for (int bj = 0; bj < 2; ++bj)
#pragma unroll
                        for (int n = 0; n < 2; ++n) { const i32x4 iv = __builtin_bit_cast(i32x4, acc[ai][bj][m][n]);
#pragma unroll
                            for (int j = 0; j < 4; ++j) acc[ai][bj][m][n][j] = (float)iv[j] * r * cv[bj][n][j]; } }
        }
        float w0[8], w1[8], w2[8], bb[8];
#pragma unroll
        for (int h = 0; h < 2; ++h) { const f32x4 a0 = *(const f32x4*)(cw + colg + 4 * h), a1 = *(const f32x4*)(cw + DFF + colg + 4 * h), a2 = *(const f32x4*)(cw + 2 * DFF + colg + 4 * h), a3 = *(const f32x4*)(cb + colg + 4 * h);
#pragma unroll
            for (int i = 0; i < 4; ++i) { w0[4 * h + i] = a0[i]; w1[4 * h + i] = a1[i]; w2[4 * h + i] = a2[i]; bb[4 * h + i] = a3[i]; } }
#pragma unroll
        for (int ai = 0; ai < 2; ++ai) {
            const int blk = 4 * u.pm + 2 * ai + wr;
#pragma unroll
            for (int m = 0; m < 4; ++m) {
                float g[8], sv[8];
#pragma unroll
                for (int e = 0; e < 8; ++e) { const int n = e >> 2, j = e & 3;
                    const float a = acc[ai][0][m][n][j], uu = acc[ai][1][m][n][j];
                    const float tp = (m > 0 && fr == 15) ? acc[ai][0][m > 0 ? m - 1 : 0][n][j] : a;
                    const float tn = (m < 3 && fr == 0) ? acc[ai][0][m < 3 ? m + 1 : 3][n][j] : a;
                    float prev = dppf<0x121>(tp), next = dppf<0x12F>(tn);
                    if (m == 0 && fr == 0) prev = 0.f;
                    if (m == 3 && fr == 15) next = 0.f;
                    const float v = w0[e] * prev + w1[e] * a + w2[e] * next + bb[e];
                    sv[e] = v; g[e] = v * __builtin_amdgcn_rcpf(1.f + __expf(-v)) * uu; }
                const int row = u.pm * BM + ai * HALF + wr * 64 + m * 16 + fr;
                u32x4 w; w.x = cvt_pk_bf16(g[0], g[1]); w.y = cvt_pk_bf16(g[2], g[3]); w.z = cvt_pk_bf16(g[4], g[5]); w.w = cvt_pk_bf16(g[6], g[7]);
                *(u32x4*)(G + (size_t)row * DFF + colg) = w;
                if ((m == 0 && fr == 0) || (m == 3 && fr == 15)) {
                    const size_t eo = ((size_t)blk * 2 + (m == 0 ? 0 : 1)) * DFF + colg;
#pragma unroll
                    for (int h = 0; h < 2; ++h) {
                        *(f32x4*)(ES + eo + 4 * h) = (f32x4){sv[4 * h], sv[4 * h + 1], sv[4 * h + 2], sv[4 * h + 3]};
                        *(f32x4*)(EA + eo + 4 * h) = acc[ai][0][m][h];
                        *(f32x4*)(EU + eo + 4 * h) = acc[ai][1][m][h]; }
                }
                asm volatile("" ::: "memory");
            }
        }
    }
};

#ifndef PG8_SP2
#define PG8_SP2 true
#endif
#ifndef PG8_ALIGN
#define PG8_ALIGN true
#endif
template <class Epi, bool I8 = false, bool ALIGN_EPI = PG8_ALIGN, bool SP2 = PG8_SP2>
__device__ __forceinline__ void gemm_phase(LAS unsigned char* lds, const Gemm g, const StaticOrder& S, const Epi& E) {
    const int tid = opaque_tid(), wid = __builtin_amdgcn_readfirstlane(tid >> 6), lane = tid & 63, wr = wid >> 2, wc = wid & 3, fr = lane & 15, fq = lane >> 4;
    const int PB = g.PB;
    unsigned voffA[2], voffB[2];
#pragma unroll
    for (int i = 0; i < 2; ++i) { int R, C; stage_rc(tid * 16 + i * 8192, R, C); const int Rb = Epi::PERM ? ((R & ~31) + perm32(R & 31)) : R;
        voffA[i] = (unsigned)(R * PB + C * 2); voffB[i] = (unsigned)(Rb * PB + C * 2); }
    const size_t kstep = (size_t)(BK * 2);
    const size_t hstep = (size_t)HALF * PB;
    const size_t tstep = 2 * hstep;
    const unsigned ldsw = (unsigned)wid * 1024u;
    const int aoff = lds_byte(wr * 64 + fr, fq * 8), boff = lds_byte(wc * 32 + fr, fq * 8);
#define PG8_SA(b, h) (((b) * 2 + (h)) * HTB)
#define PG8_SB(b, h) ((4 + (b) * 2 + (h)) * HTB)
#define PG8_STAGE(bufoff, gbase, voff) do { _Pragma("unroll") for (int _i = 0; _i < 2; ++_i) \
        __builtin_amdgcn_global_load_lds((const unsigned*)((const char*)(gbase) + (voff)[_i]), (LAS unsigned*)(lds + (bufoff) + ldsw + _i * 8192), 16, 0, 0); } while (0)
#define PG8_LDA(dst, b, h) do { _Pragma("unroll") for (int m = 0; m < 4; ++m) _Pragma("unroll") for (int k = 0; k < 2; ++k) dst[m][k] = *(const LAS bf16x8*)(lds + PG8_SA(b, h) + aoff + m * 2048 + k * 1024); } while (0)
#define PG8_LDB(dst, b, h) do { _Pragma("unroll") for (int n = 0; n < 2; ++n) _Pragma("unroll") for (int k = 0; k < 2; ++k) dst[n][k] = *(const LAS bf16x8*)(lds + PG8_SB(b, h) + boff + n * 2048 + k * 1024); } while (0)
#define PG8_MMA(ai, bj, At, Bt) do { __builtin_amdgcn_s_setprio(1); _Pragma("unroll") for (int m = 0; m < 4; ++m) _Pragma("unroll") for (int n = 0; n < 2; ++n) _Pragma("unroll") for (int k = 0; k < 2; ++k) \
        { if constexpr (I8) acc[ai][bj][m][n] = __builtin_bit_cast(f32x4, __builtin_amdgcn_mfma_i32_16x16x64_i8(__builtin_bit_cast(i32x4, Bt[n][k]), __builtin_bit_cast(i32x4, At[m][k]), __builtin_bit_cast(i32x4, acc[ai][bj][m][n]), 0, 0, 0)); \
          else acc[ai][bj][m][n] = __builtin_amdgcn_mfma_f32_16x16x32_bf16(Bt[n][k], At[m][k], acc[ai][bj][m][n], 0, 0, 0); } __builtin_amdgcn_s_setprio(0); } while (0)
#define PG8_WAIT_V(n) asm volatile("s_waitcnt vmcnt(" #n ")" ::: "memory")
#define PG8_WAIT_L(n) asm volatile("s_waitcnt lgkmcnt(" #n ")" ::: "memory")
#define PG8_BAR __builtin_amdgcn_s_barrier()
#define PG8_SCHED __builtin_amdgcn_sched_barrier(0)
    constexpr int SEGN = Epi::SEGN;
    Unit cur, nxt; int ui = 0;
    if (!S.template next<SEGN>(0, cur)) return;
    f32x4 acc[2][2][4][2];
#pragma unroll
    for (int a = 0; a < 2; ++a)
#pragma unroll
        for (int b = 0; b < 2; ++b)
#pragma unroll
            for (int m = 0; m < 4; ++m)
#pragma unroll
                for (int n = 0; n < 2; ++n) acc[a][b][m][n] = (f32x4){0.f, 0.f, 0.f, 0.f};
    bf16x8 At[4][2], B0[2][2], B1[2][2];
    const char* cA = (const char*)g.A + (size_t)cur.pm * tstep + (size_t)cur.k0 * kstep; const char* cB = (const char*)g.Bt + (size_t)cur.pn * tstep + (size_t)cur.k0 * kstep;
    if constexpr (SP2) {
        PG8_STAGE(PG8_SB(0, 0), cB, voffB); PG8_STAGE(PG8_SB(0, 1), cB + hstep, voffB); PG8_STAGE(PG8_SA(0, 0), cA, voffA); PG8_STAGE(PG8_SA(0, 1), cA + hstep, voffA);
        if (wr == 1) PG8_BAR;
        PG8_WAIT_V(2); PG8_BAR;
        PG8_STAGE(PG8_SB(1, 0), cB + kstep, voffB); PG8_STAGE(PG8_SA(1, 0), cA + kstep, voffA); PG8_STAGE(PG8_SB(1, 1), cB + hstep + kstep, voffB);
        PG8_WAIT_V(6); PG8_BAR;
    } else {
    PG8_STAGE(PG8_SB(0, 0), cB, voffB); PG8_STAGE(PG8_SA(0, 0), cA, voffA); PG8_STAGE(PG8_SB(0, 1), cB + hstep, voffB); PG8_STAGE(PG8_SA(0, 1), cA + hstep, voffA);
    if (wr == 1) PG8_BAR;
    PG8_WAIT_V(4); PG8_BAR;
    PG8_STAGE(PG8_SB(1, 0), cB + kstep, voffB); PG8_STAGE(PG8_SA(1, 0), cA + kstep, voffA); PG8_STAGE(PG8_SB(1, 1), cB + hstep + kstep, voffB);
    PG8_WAIT_V(6); PG8_BAR;
    }
    for (;;) {
        const bool has_next = S.template next<SEGN>(ui + 1, nxt);
        const char* nA = has_next ? (const char*)g.A + (size_t)nxt.pm * tstep + (size_t)nxt.k0 * kstep : cA; const char* nB = has_next ? (const char*)g.Bt + (size_t)nxt.pn * tstep + (size_t)nxt.k0 * kstep : cB;
        const int ntc = cur.ntk;
        for (int t = 0; t < ntc; t += 2) {
            const bool last = (t == ntc - 2);
            const char* a1 = cA + (size_t)(t + 1) * kstep;
            const char* a2 = last ? nA : cA + (size_t)(t + 2) * kstep; const char* b2 = last ? nB : cB + (size_t)(t + 2) * kstep;
            const char* a3 = a2 + kstep; const char* b3 = b2 + kstep;
            if constexpr (SP2) {
            PG8_LDB(B0, 0, 0); PG8_LDB(B1, 0, 1); PG8_SCHED; PG8_LDA(At, 0, 0); PG8_STAGE(PG8_SA(1, 1), a1 + hstep, voffA);
            PG8_WAIT_V(8); PG8_WAIT_L(0); PG8_BAR; PG8_MMA(0, 0, At, B0); PG8_MMA(0, 1, At, B1); PG8_BAR; PG8_SCHED;
            PG8_LDA(At, 0, 1); PG8_STAGE(PG8_SB(0, 0), b2, voffB); PG8_STAGE(PG8_SB(0, 1), b2 + hstep, voffB); PG8_STAGE(PG8_SA(0, 0), a2, voffA);
            PG8_WAIT_V(8); PG8_WAIT_L(0); PG8_BAR; PG8_MMA(1, 0, At, B0); PG8_MMA(1, 1, At, B1); PG8_BAR; PG8_SCHED;
            PG8_LDB(B0, 1, 0); PG8_LDB(B1, 1, 1); PG8_SCHED; PG8_LDA(At, 1, 0); PG8_STAGE(PG8_SA(0, 1), a2 + hstep, voffA);
            PG8_WAIT_V(8); PG8_WAIT_L(0); PG8_BAR; PG8_MMA(0, 0, At, B0); PG8_MMA(0, 1, At, B1); PG8_BAR; PG8_SCHED;
            PG8_LDA(At, 1, 1); PG8_STAGE(PG8_SB(1, 0), b3, voffB); PG8_STAGE(PG8_SB(1, 1), b3 + hstep, voffB); PG8_STAGE(PG8_SA(1, 0), a3, voffA);
            PG8_WAIT_V(8); PG8_WAIT_L(0); PG8_BAR; PG8_MMA(1, 0, At, B0); PG8_MMA(1, 1, At, B1); PG8_BAR; PG8_SCHED;
            } else {
            PG8_LDB(B0, 0, 0); PG8_SCHED; PG8_LDA(At, 0, 0); PG8_STAGE(PG8_SA(1, 1), a1 + hstep, voffA);
            PG8_WAIT_L(8); PG8_BAR; PG8_WAIT_L(0); PG8_MMA(0, 0, At, B0); PG8_BAR; PG8_SCHED;
            PG8_LDB(B1, 0, 1); PG8_STAGE(PG8_SB(0, 0), b2, voffB);
            PG8_BAR; PG8_WAIT_L(0); PG8_MMA(0, 1, At, B1); PG8_BAR;
            PG8_LDA(At, 0, 1); PG8_STAGE(PG8_SA(0, 0), a2, voffA);
            PG8_BAR; PG8_WAIT_L(0); PG8_MMA(1, 0, At, B0); PG8_BAR; PG8_SCHED;
            PG8_STAGE(PG8_SB(0, 1), b2 + hstep, voffB);
            PG8_WAIT_V(6); PG8_BAR; PG8_MMA(1, 1, At, B1); PG8_BAR;
            PG8_LDB(B0, 1, 0); PG8_SCHED; PG8_LDA(At, 1, 0); PG8_STAGE(PG8_SA(0, 1), a2 + hstep, voffA);
            PG8_WAIT_L(8); PG8_BAR; PG8_WAIT_L(0); PG8_MMA(0, 0, At, B0); PG8_BAR; PG8_SCHED;
            PG8_LDB(B1, 1, 1); PG8_STAGE(PG8_SB(1, 0), b3, voffB);
            PG8_BAR; PG8_WAIT_L(0); PG8_MMA(0, 1, At, B1); PG8_BAR;
            PG8_LDA(At, 1, 1); PG8_STAGE(PG8_SA(1, 0), a3, voffA);
            PG8_BAR; PG8_WAIT_L(0); PG8_MMA(1, 0, At, B0); PG8_BAR; PG8_SCHED;
            PG8_STAGE(PG8_SB(1, 1), b3 + hstep, voffB);
            PG8_WAIT_V(6); PG8_BAR; PG8_MMA(1, 1, At, B1); PG8_BAR;
            }
        }
        if constexpr (ALIGN_EPI) { if (wr == 0) PG8_BAR; }
        E(acc, cur, wr, wc, fr, fq);
        if (!has_next) break;
        if (SEGN == 1 || cur.seg == SEGN - 1) {
#pragma unroll
        for (int a = 0; a < 2; ++a)
#pragma unroll
            for (int b = 0; b < 2; ++b)
#pragma unroll
                for (int m = 0; m < 4; ++m)
#pragma unroll
                    for (int n = 0; n < 2; ++n) acc[a][b][m][n] = (f32x4){0.f, 0.f, 0.f, 0.f};
        }
        cur = nxt; cA = nA; cB = nB; ++ui;
        if constexpr (ALIGN_EPI) { if (wr == 1) PG8_BAR; }
    }
    PG8_WAIT_V(0);
    if constexpr (!ALIGN_EPI) { if (wr == 0) PG8_BAR; }
    PG8_BAR;
#undef PG8_SA
#undef PG8_SB
#undef PG8_STAGE
#undef PG8_LDA
#undef PG8_LDB
#undef PG8_MMA
#undef PG8_WAIT_V
#undef PG8_WAIT_L
#undef PG8_BAR
#undef PG8_SCHED
}
}

namespace att {
constexpr int D = 128, NW = 8, QBLK = 32, KVBLK = 64;
constexpr float SCALE = 0.088388347648318440f;
constexpr float THR = 8.f;
#ifndef ATT_SDEPTH
#define ATT_SDEPTH 1
#endif
constexpr int SDEPTH = ATT_SDEPTH;
constexpr int LDQ = QP, LDK = QP, LDO = DM;
constexpr size_t SHM_V = KVBLK * D * 2, SHM_K = KVBLK * D * 2, SHM_ATTN = 2 * SHM_V + 2 * SHM_K + NW * 64 * 4;
constexpr int BTAB_OFF = (int)SHM_ATTN;
constexpr int RTAB_OFF = BTAB_OFF + 2048;
#define KSWZ(row, colB) ((row) * 256 + ((colB) ^ (((row) & 7) << 4)))
#define SBAR() __builtin_amdgcn_sched_barrier(0)
__device__ __forceinline__ int crow(int r, int hi) { return (r & 3) + 8 * (r >> 2) + 4 * hi; }

struct Args {
    const bf16_t* Qb;
    const bf16_t* Kb;
    const bf16_t* Vb;
    bf16_t* Ob;
    int ctx_row0, lat_row0, NT;
    float sink_l2;
    int abase;
    int b_r0, b_rs0;
    const float* qg;
    int q_rope, q_t0;
};

__device__ __forceinline__ void partialSM(f32x16& p0, f32x16& p1, float& m_reg, float& mn, float& alpha) {
    constexpr float C = SCALE * 1.4426950408889634f;
    float pmax = p0[0];
#pragma unroll
    for (int r = 1; r < 16; ++r) pmax = fmaxf(pmax, p0[r]);
#pragma unroll
    for (int r = 0; r < 16; ++r) pmax = fmaxf(pmax, p1[r]);
    { auto rr = __builtin_amdgcn_permlane32_swap(__float_as_uint(pmax), __float_as_uint(pmax), false, false);
      pmax = fmaxf(__uint_as_float(rr[0]), __uint_as_float(rr[1])); }
    if (__builtin_expect(__all(pmax - m_reg <= THR / SCALE), 1)) { mn = m_reg; alpha = 1.f; }
    else { mn = fmaxf(m_reg, pmax); alpha = __builtin_amdgcn_exp2f((m_reg - mn) * C); m_reg = mn; }
    float mnC = -mn * C;
#pragma unroll
    for (int r = 0; r < 16; ++r) p0[r] = fmaf(p0[r], C, mnC);
#pragma unroll
    for (int r = 0; r < 16; ++r) p1[r] = fmaf(p1[r], C, mnC);
#pragma unroll
    for (int r = 0; r < 16; ++r) p0[r] = __builtin_amdgcn_exp2f(p0[r]);
}
__device__ __forceinline__ void finishSM(f32x16& p0, f32x16& p1, float alpha, float& l_reg, bf16x8& pa0, bf16x8& pa1, bf16x8& pa2, bf16x8& pa3) {
#pragma unroll
    for (int r = 0; r < 16; ++r) p1[r] = __builtin_amdgcn_exp2f(p1[r]);
    float ps = 0;
#pragma unroll
    for (int r = 0; r < 16; ++r) ps += p0[r];
#pragma unroll
    for (int r = 0; r < 16; ++r) ps += p1[r];
    { auto rr = __builtin_amdgcn_permlane32_swap(__float_as_uint(ps), __float_as_uint(ps), false, false);
      ps = __uint_as_float(rr[0]) + __uint_as_float(rr[1]); }
    l_reg = l_reg * alpha + ps;
#define PK4(P, BASE, OUT) do { unsigned a0 = cvt_pk_bf16(P[BASE + 0], P[BASE + 1]), a1 = cvt_pk_bf16(P[BASE + 2], P[BASE + 3]);   \
    unsigned b0 = cvt_pk_bf16(P[BASE + 4], P[BASE + 5]), b1 = cvt_pk_bf16(P[BASE + 6], P[BASE + 7]);                              \
    auto r0 = __builtin_amdgcn_permlane32_swap(a0, b0, false, false); auto r1 = __builtin_amdgcn_permlane32_swap(a1, b1, false, false); \
    u32x4 w = {r0[0], r1[0], r0[1], r1[1]}; OUT = *reinterpret_cast<bf16x8*>(&w); } while (0)
    PK4(p0, 0, pa0); PK4(p0, 8, pa1); PK4(p1, 0, pa2); PK4(p1, 8, pa3);
#undef PK4
}
__device__ __forceinline__ void qkt(f32x16& p0, f32x16& p1, const char* Ks, const bf16x8* qr, int r32, int hi) {
    p0 = f32x16{}; p1 = f32x16{};
#pragma unroll
    for (int d0 = 0; d0 < 8; ++d0) { int cb = (d0 * 16 + hi * 8) * 2;
        bf16x8 b0 = *reinterpret_cast<const bf16x8*>(Ks + KSWZ(r32, cb));
        bf16x8 b1 = *reinterpret_cast<const bf16x8*>(Ks + KSWZ(32 + r32, cb));
        p0 = __builtin_amdgcn_mfma_f32_32x32x16_bf16(b0, qr[d0], p0, 0, 0, 0);
        p1 = __builtin_amdgcn_mfma_f32_32x32x16_bf16(b1, qr[d0], p1, 0, 0, 0); }
}
__device__ __forceinline__ int v_st(int k, int c) { const int kk = (k & ~0xC) | ((k & 4) << 1) | ((k & 8) >> 1); return ((kk >> 3) * 4 + (c >> 5)) * 512 + ((kk & 7) * 32 + (c & 31)) * 2; }
__device__ __forceinline__ int v_rd_base(int lane) { return ((lane & 3) << 3) | (((lane >> 2) & 3) << 6) | (((lane >> 4) & 1) << 5) | (((lane >> 5) & 1) << 8); }
constexpr int v_rd_off(int d0, int ks, int half) { return d0 * 512 + ks * 4096 + half * 2048; }
template <int OFF> __device__ __forceinline__ s16x4 tr_read(int vb) {
    s16x4 r; asm volatile("ds_read_b64_tr_b16 %0, %1 offset:%2" : "=&v"(r) : "v"(vb), "i"(OFF) : "memory"); return r;
}
template <int D0> __device__ __forceinline__ void pv_one(f32x16& od, int vb, bf16x8 pa0, bf16x8 pa1, bf16x8 pa2, bf16x8 pa3) {
    const s16x4 l0 = tr_read<v_rd_off(D0, 0, 0)>(vb), h0 = tr_read<v_rd_off(D0, 0, 1)>(vb), l1 = tr_read<v_rd_off(D0, 1, 0)>(vb), h1 = tr_read<v_rd_off(D0, 1, 1)>(vb);
    const s16x4 l2 = tr_read<v_rd_off(D0, 2, 0)>(vb), h2 = tr_read<v_rd_off(D0, 2, 1)>(vb), l3 = tr_read<v_rd_off(D0, 3, 0)>(vb), h3 = tr_read<v_rd_off(D0, 3, 1)>(vb);
    asm volatile("s_waitcnt lgkmcnt(0)" ::: "memory"); SBAR();
#define PK(L, H) (bf16x8){L[0], L[1], L[2], L[3], H[0], H[1], H[2], H[3]}
    od = __builtin_amdgcn_mfma_f32_32x32x16_bf16(pa0, PK(l0, h0), od, 0, 0, 0);
    od = __builtin_amdgcn_mfma_f32_32x32x16_bf16(pa1, PK(l1, h1), od, 0, 0, 0);
    od = __builtin_amdgcn_mfma_f32_32x32x16_bf16(pa2, PK(l2, h2), od, 0, 0, 0);
    od = __builtin_amdgcn_mfma_f32_32x32x16_bf16(pa3, PK(l3, h3), od, 0, 0, 0);
#undef PK
}
__device__ __forceinline__ void pv_d0(f32x16* o, int vb, bf16x8 pa0, bf16x8 pa1, bf16x8 pa2, bf16x8 pa3) {
    pv_one<0>(o[0], vb, pa0, pa1, pa2, pa3); pv_one<1>(o[1], vb, pa0, pa1, pa2, pa3); pv_one<2>(o[2], vb, pa0, pa1, pa2, pa3); pv_one<3>(o[3], vb, pa0, pa1, pa2, pa3);
}

#ifndef SKIP_A
#define SKIP_A 1
#endif
#ifndef SKIP_B
#define SKIP_B 0
#endif
template <int MODE>
__device__ __forceinline__ void apply_mask(f32x16& p0, f32x16& p1, int j, const Args& a, int wid, int r32, int hi, const float* btab) {
    if constexpr (MODE == 1) {
        if (j >= 4) {
            const int baseW = a.abase + 64 * (j - 4) - 32 * wid;
            if (!(baseW - 31 >= -128 && baseW + 63 <= 128)) {
                const int base = baseW - r32;
#pragma unroll
                for (int r = 0; r < 16; ++r) { const int d0 = base + crow(r, hi), d1 = d0 + 32;
                    if (d0 < -128 || d0 > 128) p0[r] = -1e30f;
                    if (d1 < -128 || d1 > 128) p1[r] = -1e30f; }
            }
        }
    } else if constexpr (MODE == 2) {
        if (j >= 4) {
            const int kr = a.b_rs0 + (j - 4), qr = a.b_r0 + (wid >> 1);
            const int rs = min(max(qr - 4, 0), 56);
            if (!SKIP_B && (kr < rs || kr >= rs + 8)) {
#pragma unroll
                for (int r = 0; r < 16; ++r) { p0[r] = -1e30f; p1[r] = -1e30f; }
            } else {
                const int qc = (wid & 1) * 32 + r32, cs = min(max(qc - 8, 0), 48);
                const float* tb = btab + (kr - qr + 7) * 31;
#pragma unroll
                for (int r = 0; r < 16; ++r) { const int k0 = crow(r, hi), k1 = k0 + 32;
                    const float b0 = tb[min(max(k0 - qc + 15, 0), 30)], b1 = tb[min(max(k1 - qc + 15, 0), 30)];
                    p0[r] = (k0 >= cs && k0 < cs + 16) ? p0[r] + b0 : -1e30f;
                    p1[r] = (k1 >= cs && k1 < cs + 16) ? p1[r] + b1 : -1e30f;
                    if ((r & 3) == 3) asm volatile("" ::: "memory"); }
            }
        }
    }
}

template <int MODE>
__device__ __forceinline__ bool tile_dead(int j, const Args& a, int wid) {
    if constexpr (MODE == 1 && SKIP_A) { if (j < 4) return false; const int baseW = a.abase + 64 * (j - 4) - 32 * wid; return (baseW - 31 > 128) || (baseW + 63 < -128); }
    else if constexpr (MODE == 2 && SKIP_B) { if (j < 4) return false; const int kr = a.b_rs0 + (j - 4), qr = a.b_r0 + (wid >> 1), rs = min(max(qr - 4, 0), 56); return kr < rs || kr >= rs + 8; }
    else return false;
}
template <int MODE>
__device__ __forceinline__ void attn_body(const Args& a, char* lds) {
    const int tid = opaque_tid(), wid = __builtin_amdgcn_readfirstlane(tid >> 6), lane = tid & 63, r32 = lane & 31, hi = lane >> 5;
    char* V_lds = lds; char* K_lds = lds + 2 * SHM_V;
    float* ws = (float*)(lds + 2 * SHM_V + 2 * SHM_K) + wid * 64; float* li_l = ws; float* al_l = ws + 32;
    const float* btab = (const float*)(lds + BTAB_OFF);
    float m_reg = -1e30f, l_reg = 0; f32x16 o[4] = {}; bf16x8 qr[8];
    const bf16_t* Qw = a.Qb + (long)(wid * QBLK + r32) * LDQ + hi * 8;
#pragma unroll
    for (int d0 = 0; d0 < 8; ++d0) qr[d0] = *reinterpret_cast<const bf16x8*>(Qw + d0 * 16);
    if (a.qg != nullptr || a.q_rope) {
        float q[8][8];
#pragma unroll
        for (int d0 = 0; d0 < 8; ++d0) { const u32x4 w = *reinterpret_cast<const u32x4*>(&qr[d0]);
#pragma unroll
            for (int c = 0; c < 4; ++c) { q[d0][2 * c] = bf_lo(w[c]); q[d0][2 * c + 1] = bf_hi(w[c]); } }
        if (a.qg != nullptr) {
            float ss = 0.f;
#pragma unroll
            for (int d0 = 0; d0 < 8; ++d0)
#pragma unroll
                for (int i = 0; i < 8; ++i) ss += q[d0][i] * q[d0][i];
            { auto rr = __builtin_amdgcn_permlane32_swap(__float_as_uint(ss), __float_as_uint(ss), false, false); ss = __uint_as_float(rr[0]) + __uint_as_float(rr[1]); }
            const float rstd = rsqrtf(ss * (1.f / 128.f) + EPS);
#pragma unroll
            for (int d0 = 0; d0 < 8; ++d0) { const f32x4 g0 = *(const f32x4*)(a.qg + d0 * 16 + hi * 8), g1 = *(const f32x4*)(a.qg + d0 * 16 + hi * 8 + 4);
#pragma unroll
                for (int i = 0; i < 4; ++i) { q[d0][i] *= rstd * g0[i]; q[d0][4 + i] *= rstd * g1[i]; } }
        }
        if (a.q_rope) {
            const float2* rtab = (const float2*)(lds + RTAB_OFF);
            const int t = a.q_t0 + wid * QBLK + r32;
#pragma unroll
            for (int hb = 0; hb < 2; ++hb) { const int pos = hb ? (t & 63) : (t >> 6);
#pragma unroll
                for (int dd = 0; dd < 2; ++dd) { const int d0 = hb * 4 + dd;
#pragma unroll
                    for (int i = 0; i < 8; ++i) { const float2 cs = rtab[pos * 32 + dd * 16 + hi * 8 + i]; const float x1 = q[d0][i], x2 = q[d0 + 2][i];
                        q[d0][i] = x1 * cs.x - x2 * cs.y; q[d0 + 2][i] = x2 * cs.x + x1 * cs.y; } } }
        }
#pragma unroll
        for (int d0 = 0; d0 < 8; ++d0) { u32x4 w; w.x = cvt_pk_bf16(q[d0][0], q[d0][1]); w.y = cvt_pk_bf16(q[d0][2], q[d0][3]); w.z = cvt_pk_bf16(q[d0][4], q[d0][5]); w.w = cvt_pk_bf16(q[d0][6], q[d0][7]);
            qr[d0] = *reinterpret_cast<bf16x8*>(&w); }
    }
    const int sr = tid >> 4, sc = (tid & 15) * 8, vst0 = v_st(sr, sc), vst1 = v_st(32 + sr, sc);
    const int vb0 = (int)(uintptr_t)V_lds + v_rd_base(lane);
    struct { bf16x8 vs0, vs1, ks0, ks1; } sr_[SDEPTH];
    const unsigned goff = (unsigned)(sr * LDK + sc) * 2u, goff1 = goff + 32u * LDK * 2u;
#define KROW(j) ((j) < 4 ? a.ctx_row0 + 64 * (j) : a.lat_row0 + 64 * ((j) - 4))
#define SLOAD(i, j) do { const size_t _kb = (size_t)KROW(j) * (LDK * 2); const char* _vp = (const char*)a.Vb + _kb; const char* _kp = (const char*)a.Kb + _kb; \
    sr_[i].vs0 = *(const bf16x8*)(_vp + goff); sr_[i].vs1 = *(const bf16x8*)(_vp + goff1); \
    sr_[i].ks0 = *(const bf16x8*)(_kp + goff); sr_[i].ks1 = *(const bf16x8*)(_kp + goff1); } while (0)
#define SWRITE(b, i) do { *(bf16x8*)(V_lds + (b) * SHM_V + vst0) = sr_[i].vs0;          \
    *(bf16x8*)(V_lds + (b) * SHM_V + vst1) = sr_[i].vs1; int kc = sc * 2;               \
    *(bf16x8*)(K_lds + (b) * SHM_K + KSWZ(sr, kc)) = sr_[i].ks0;                       \
    *(bf16x8*)(K_lds + (b) * SHM_K + KSWZ(32 + sr, kc)) = sr_[i].ks1; } while (0)
#define SWAIT() do { if constexpr (SDEPTH == 2) asm volatile("s_waitcnt vmcnt(4)" ::: "memory"); else asm volatile("s_waitcnt vmcnt(0)" ::: "memory"); } while (0)
#define RESC(al) do { if (__any((al) < 1.f)) { if (hi == 0) al_l[r32] = (al); asm volatile("s_waitcnt lgkmcnt(0)" ::: "memory"); \
    _Pragma("unroll") for (int d = 0; d < 4; ++d) _Pragma("unroll") for (int r = 0; r < 16; ++r) o[d][r] *= al_l[crow(r, hi)]; } } while (0)
    f32x16 pA0, pA1, pB0, pB1; float mnA, mnB, alA, alB; bf16x8 pa0, pa1, pa2, pa3; const int NT = a.NT;
    constexpr int SE = 0, SO = SDEPTH - 1;
    SLOAD(SE, 0); asm volatile("s_waitcnt vmcnt(0)" ::: "memory"); SWRITE(0, SE); __syncthreads();
    qkt(pA0, pA1, K_lds, qr, r32, hi); partialSM(pA0, pA1, m_reg, mnA, alA);
    SLOAD(SO, 1); if constexpr (SDEPTH == 2) { if (2 < NT) SLOAD(SE, 2); }
    SWAIT(); SWRITE(1, SO); __syncthreads();
    bool dA = false, dB = false;
    for (int j = 1; j + 1 < NT; j += 2) {
        dB = tile_dead<MODE>(j, a, wid);
        SBAR(); if (!dB) qkt(pB0, pB1, K_lds + SHM_K, qr, r32, hi);
        if (!dA) finishSM(pA0, pA1, alA, l_reg, pa0, pa1, pa2, pa3); SBAR();
        SLOAD(SO, j + SDEPTH); SBAR();
        if (!dA) pv_d0(o, vb0, pa0, pa1, pa2, pa3);
        if (!dB) { apply_mask<MODE>(pB0, pB1, j, a, wid, r32, hi, btab); partialSM(pB0, pB1, m_reg, mnB, alB); } else alB = 1.f;
        __syncthreads(); SWAIT(); SWRITE(0, SE);
        RESC(alB); __syncthreads();
        dA = tile_dead<MODE>(j + 1, a, wid);
        SBAR(); if (!dA) qkt(pA0, pA1, K_lds, qr, r32, hi);
        if (!dB) finishSM(pB0, pB1, alB, l_reg, pa0, pa1, pa2, pa3); SBAR();
        if (SDEPTH == 1 || j + 3 < NT) SLOAD(SE, j + 1 + SDEPTH); SBAR();
        if (!dB) pv_d0(o, vb0 + (int)SHM_V, pa0, pa1, pa2, pa3);
        if (!dA) { apply_mask<MODE>(pA0, pA1, j + 1, a, wid, r32, hi, btab); partialSM(pA0, pA1, m_reg, mnA, alA); } else alA = 1.f;
        __syncthreads(); SWAIT(); SWRITE(1, SO);
        RESC(alA); __syncthreads();
    }
    dB = tile_dead<MODE>(NT - 1, a, wid);
    SBAR(); if (!dB) qkt(pB0, pB1, K_lds + SHM_K, qr, r32, hi);
    if (!dA) finishSM(pA0, pA1, alA, l_reg, pa0, pa1, pa2, pa3); SBAR();
    if (!dA) pv_d0(o, vb0, pa0, pa1, pa2, pa3);
    if (!dB) { apply_mask<MODE>(pB0, pB1, NT - 1, a, wid, r32, hi, btab); partialSM(pB0, pB1, m_reg, mnB, alB); } else alB = 1.f;
    __syncthreads(); RESC(alB);
    if (!dB) { finishSM(pB0, pB1, alB, l_reg, pa0, pa1, pa2, pa3); SBAR();
        pv_d0(o, vb0 + (int)SHM_V, pa0, pa1, pa2, pa3); }
    l_reg += __builtin_amdgcn_exp2f(a.sink_l2 - m_reg * (SCALE * 1.4426950408889634f));
    if (hi == 0) li_l[r32] = l_reg; asm volatile("s_waitcnt lgkmcnt(0)" ::: "memory");
    float rli[16];
#pragma unroll
    for (int r = 0; r < 16; ++r) rli[r] = __builtin_amdgcn_rcpf(li_l[crow(r, hi)]);
    const int odd = lane & 1;
    char* Ow = (char*)(a.Ob + (long)(wid * QBLK + 4 * hi + odd) * LDO + (r32 & ~1));
#pragma unroll
    for (int r = 0; r < 16; r += 2) {
#pragma unroll
        for (int d0 = 0; d0 < 4; ++d0) { const float va = o[d0][r] * rli[r], vb = o[d0][r + 1] * rli[r + 1];
            const float recv = xor_swz<1>(odd ? va : vb);
            const unsigned w = odd ? cvt_pk_bf16(recv, vb) : cvt_pk_bf16(va, recv);
            *(unsigned*)(Ow + ((r & 3) + 8 * (r >> 2)) * (LDO * 2) + d0 * 64) = w; } }
#undef KROW
#undef SLOAD
#undef SWRITE
#undef SWAIT
#undef RESC
}
}

__device__ __forceinline__ const float* xrow_c(const Params& p, int row, bool from_input) { return row < MLAT ? (from_input ? p.x : p.out) + (size_t)row * DM : (const float*)(p.ws + WS_XC) + (size_t)(row - MLAT) * DM; }
__device__ __forceinline__ int row_set(int row) { return row < MLAT ? (row >> 12) : 4; }

__device__ __forceinline__ void convert_tile(const float* __restrict__ W, bf16_t* __restrict__ WT, int K, int N, int kt, int nt, unsigned* l32, int nout0) {
    const int tid = opaque_tid(), n4 = tid & 15, kp = tid >> 4;
    const int k0 = kt * 256, n0 = nt * 64;
    __syncthreads();
#pragma unroll
    for (int it = 0; it < 4; ++it) {
        const int k = k0 + it * 64 + kp * 2;
        const f32x4 a = *(const f32x4*)(W + (size_t)k * N + n0 + n4 * 4), b = *(const f32x4*)(W + (size_t)(k + 1) * N + n0 + n4 * 4);
#pragma unroll
        for (int j = 0; j < 4; ++j) l32[(n4 * 4 + j) * 132 + it * 32 + kp] = cvt_pk_bf16(a[j], b[j]);
    }
    __syncthreads();
    const int n = tid >> 3, kc = tid & 7;
    const u32x4* src = (const u32x4*)(l32 + n * 132 + kc * 16);
    u32x4* dst = (u32x4*)(WT + (size_t)(nout0 + n) * K + k0 + kc * 32);
#pragma unroll
    for (int q = 0; q < 4; ++q) dst[q] = src[q];
}
__device__ void convert_weights(const Params& p, int l, unsigned char* lds, int mask) {
    bf16_t* WT = (bf16_t*)(p.ws + WS_WT);
    constexpr int T0 = 1280, T1 = T0 + 256, T2 = T1 + 256, T3 = T2 + 1408, T4 = T3 + 704;
    const int c0 = (mask & 1) ? 1280 : 0, c1 = (mask & 2) ? 256 : 0, c2 = (mask & 4) ? 256 : 0, c3 = (mask & 8) ? 1408 : 0, c4 = (mask & 16) ? 704 : 0;
    const int total = c0 + c1 + c2 + c3 + c4;
    const bool skew = (l == 0 && mask == 31 && gridDim.x == 256);
    const int id0 = skew ? (blockIdx.x < 192 ? (int)blockIdx.x : 2688 + (int)blockIdx.x - 192) : (int)blockIdx.x;
    const int idstep = skew ? (blockIdx.x < 192 ? 192 : 64) : (int)gridDim.x;
    const int idend = skew ? (blockIdx.x < 192 ? 2688 : T4) : total;
    for (int cid = id0; cid < idend; cid += idstep) {
        int r = cid, id;
        if (r < c0) id = r; else { r -= c0; if (r < c1) id = T0 + r; else { r -= c1; if (r < c2) id = T1 + r; else { r -= c2; if (r < c3) id = T2 + r; else id = T3 + (r - c3); } } }
        const float* W; bf16_t* O; int K, N, t;
        if (id < T0) { W = p.w_in + (size_t)l * DM * NQ; O = WT + WT_IN; K = DM; N = NQ; t = id; }
        else if (id < T1) { W = p.w_branch + (size_t)l * DM * DM; O = WT + WT_BR; K = DM; N = DM; t = id - T0; }
        else if (id < T2) { W = p.w_out + (size_t)l * DM * DM; O = WT + WT_OUT; K = DM; N = DM; t = id - T1; }
        else if (id < T3) { W = p.w_up + (size_t)l * DM * NUP; O = WT + WT_UP; K = DM; N = NUP; t = id - T2; }
        else { W = p.w_down + (size_t)l * DFF * DM; O = WT + WT_DOWN; K = DFF; N = DM; t = id - T3; }
        const int nnt = N / 64, n0 = (t % nnt) * 64;
        int nout0 = n0;
        if (id >= T2 && id < T3) { const int mm = n0 < DFF ? n0 : n0 - DFF; nout0 = (mm >> 7) * 256 + (n0 < DFF ? 0 : 128) + (mm & 127); }
        convert_tile(W, O, K, N, t / nnt, t % nnt, (unsigned*)lds, nout0);
    }
    __syncthreads();
}

__device__ void quant_rows(const bf16_t* __restrict__ Wt, unsigned char* __restrict__ W8, float* __restrict__ cs, int nrows) {
    const int tid = opaque_tid(), wid = tid >> 6, lane = tid & 63;
    for (int row = blockIdx.x * 8 + wid; row < nrows; row += gridDim.x * 8) {
        const u32x4* src = (const u32x4*)(Wt + (size_t)row * DM) + lane * 4;
        u32x4 w[4]; float f[32]; float mx = 0.f;
#pragma unroll
        for (int q = 0; q < 4; ++q) w[q] = src[q];
#pragma unroll
        for (int q = 0; q < 4; ++q)
#pragma unroll
            for (int c = 0; c < 4; ++c) { f[q * 8 + 2 * c] = bf_lo(w[q][c]); f[q * 8 + 2 * c + 1] = bf_hi(w[q][c]); }
#pragma unroll
        for (int i = 0; i < 32; ++i) mx = fmaxf(mx, fabsf(f[i]));
        mx = wave_max(mx);
        const float sc = mx > 0.f ? mx * (1.f / 127.f) : 1.f, inv = 1.f / sc;
        u32x4 o0, o1;
#pragma unroll
        for (int c = 0; c < 4; ++c) { o0[c] = pack_i8x4(f[4 * c] * inv, f[4 * c + 1] * inv, f[4 * c + 2] * inv, f[4 * c + 3] * inv);
                                      o1[c] = pack_i8x4(f[16 + 4 * c] * inv, f[17 + 4 * c] * inv, f[18 + 4 * c] * inv, f[19 + 4 * c] * inv); }
        u32x4* dst = (u32x4*)(W8 + (size_t)row * DM) + lane * 2;
        dst[0] = o0; dst[1] = o1;
        if (lane == 0) cs[row] = sc;
    }
}
__device__ void quant_weights(const Params& p, bool up) {
    const bf16_t* WT = (const bf16_t*)(p.ws + WS_WT);
    quant_rows(WT + WT_IN, p.ws + WS_W8IN, (float*)(p.ws + WS_CSIN), NQ);
    if (up) quant_rows(WT + WT_UP, p.ws + WS_W8UP, (float*)(p.ws + WS_CSUP), NUP);
}
__device__ void mod_phase(const Params& p, unsigned char* lds) {
    const int tid = opaque_tid();
    if ((int)blockIdx.x >= 192) return;
    float* sc = (float*)lds;
    float* red = (float*)(lds + 5 * DM * 4);
    __syncthreads();
    for (int i = tid; i < 5 * DM; i += NTHREADS) { const int s = i / DM, k = i % DM; const float v = s < 4 ? p.c[s * DM + k] : p.c_ctx[k]; sc[i] = v / (1.f + __expf(-v)); }
    __syncthreads();
    float* modv = (float*)(p.ws + WS_MOD);
    for (int it = blockIdx.x; it < 192; it += gridDim.x) {
        const int l = it / 96, cg0 = (it % 96) * 128;
        const int c4 = tid & 31, ks = tid >> 5;
        const float* W = p.w_ada + (size_t)l * DM * 6 * DM + cg0 + c4 * 4;
        f32x4 acc[5];
#pragma unroll
        for (int s = 0; s < 5; ++s) acc[s] = (f32x4){0.f, 0.f, 0.f, 0.f};
#pragma unroll 8
        for (int kk = 0; kk < 128; ++kk) { const int k = ks * 128 + kk; const f32x4 w = *(const f32x4*)(W + (size_t)k * 6 * DM);
#pragma unroll
            for (int s = 0; s < 5; ++s) acc[s] += sc[s * DM + k] * w; }
#pragma unroll
        for (int s = 0; s < 5; ++s) *(f32x4*)(red + (ks * 5 + s) * 128 + c4 * 4) = acc[s];
        __syncthreads();
        for (int i = tid; i < 5 * 128; i += NTHREADS) { const int s = i / 128, cc = i % 128; float v = p.b_ada[(size_t)l * 6 * DM + cg0 + cc];
#pragma unroll
            for (int k2 = 0; k2 < 16; ++k2) v += red[(k2 * 5 + s) * 128 + cc];
            modv[((size_t)l * 5 + s) * 6 * DM + cg0 + cc] = v; }
        __syncthreads();
    }
}

__device__ void phase_init(const Params& p, unsigned char* lds) {
    { const int tid = opaque_tid(); const f32x4* s4 = (const f32x4*)p.ctx; f32x4* d4 = (f32x4*)(p.ws + WS_XC); const long n4 = (long)MCTX * DM / 4;
      for (long i = (long)blockIdx.x * NTHREADS + tid; i < n4; i += (long)gridDim.x * NTHREADS) d4[i] = s4[i]; }
#ifdef PROBE_CONV2
    for (int rep = 0; rep < 2; ++rep) { mod_phase(p, lds); __syncthreads(); convert_weights(p, 0, lds, 31); }
#else
    mod_phase(p, lds);
    convert_weights(p, 0, lds, 31);
#endif
}

__device__ void phase_norm(const Params& p, int l, int which, int mrows, bf16_t* H, bool fold, bool q8) {
    const int tid = opaque_tid(), wid = tid >> 6, lane = tid & 63;
    const float* nw = (which ? p.norm2 : p.norm1) + (size_t)l * DM;
    const float* modl = (const float*)(p.ws + WS_MOD) + (size_t)l * 5 * 6 * DM;
    const bool from_in = (l == 0 && which == 0);
    const int stride = gridDim.x * 8;
    int row = blockIdx.x * 8 + wid;
    f32x4 v[8], vn[8];
    if (row < mrows) { const f32x4* xp = (const f32x4*)xrow_c(p, row, from_in);
#pragma unroll
        for (int i = 0; i < 8; ++i) v[i] = xp[i * 64 + lane]; }
    while (row < mrows) {
        const int nrow = row + stride;
        if (nrow < mrows) { const f32x4* xq = (const f32x4*)xrow_c(p, nrow, from_in);
#pragma unroll
            for (int i = 0; i < 8; ++i) vn[i] = xq[i * 64 + lane]; }
        const float* shift = modl + (size_t)row_set(row) * 6 * DM + (which ? 3 : 0) * DM; const float* scale = shift + DM;
        float ss = 0.f;
        if (fold && row >= MLAT) {
            const f32x4* pp = (const f32x4*)(p.ws + WS_PART) + (size_t)(row - MLAT) * (DM / 4);
#pragma unroll
            for (int s2 = 0; s2 < 8; ++s2)
#pragma unroll
                for (int i = 0; i < 8; ++i) v[i] += pp[(size_t)s2 * MCTX * (DM / 4) + i * 64 + lane];
            f32x4* xw = (f32x4*)(p.ws + WS_XC) + (size_t)(row - MLAT) * (DM / 4);
#pragma unroll
            for (int i = 0; i < 8; ++i) xw[i * 64 + lane] = v[i];
        }
#pragma unroll
        for (int i = 0; i < 8; ++i) ss += v[i][0] * v[i][0] + v[i][1] * v[i][1] + v[i][2] * v[i][2] + v[i][3] * v[i][3];
        ss = wave_sum(ss);
        const float rstd = rsqrtf(ss * (1.f / DM) + EPS);
        if (q8) {
            float mx = 0.f;
#pragma unroll
            for (int i = 0; i < 8; ++i) { const int col = (i * 64 + lane) * 4;
                const f32x4 g = *(const f32x4*)(nw + col), sh = *(const f32x4*)(shift + col), scv = *(const f32x4*)(scale + col);
                f32x4 y = v[i] * rstd * g; y = y * (1.f + scv) + sh; v[i] = y;
                mx = fmaxf(mx, fmaxf(fmaxf(fabsf(y[0]), fabsf(y[1])), fmaxf(fabsf(y[2]), fabsf(y[3])))); }
            mx = wave_max(mx);
            const float sc = mx > 0.f ? mx * (1.f / 127.f) : 1.f, inv = 1.f / sc;
            unsigned* hq = (unsigned*)((unsigned char*)H + (size_t)row * DM);
#pragma unroll
            for (int i = 0; i < 8; ++i) hq[i * 64 + lane] = pack_i8x4(v[i][0] * inv, v[i][1] * inv, v[i][2] * inv, v[i][3] * inv);
            if (lane == 0) ((float*)(p.ws + WS_RS))[row] = sc;
        } else {
#pragma unroll
        for (int i = 0; i < 8; ++i) { const int col = (i * 64 + lane) * 4;
            const f32x4 g = *(const f32x4*)(nw + col), sh = *(const f32x4*)(shift + col), scv = *(const f32x4*)(scale + col);
            f32x4 y = v[i] * rstd * g; y = y * (1.f + scv) + sh;
            u32x2 w; w.x = cvt_pk_bf16(y[0], y[1]); w.y = cvt_pk_bf16(y[2], y[3]);
            *(u32x2*)(H + (size_t)row * DM + col) = w; }
        }
#pragma unroll
        for (int i = 0; i < 8; ++i) v[i] = vn[i];
        row = nrow;
    }
}
__device__ void phase_final(const Params& p) {
    const int tid = opaque_tid(), wid = tid >> 6, lane = tid & 63;
    const int stride = gridDim.x * 8;
    int row = blockIdx.x * 8 + wid;
    f32x4 v[8], vn[8];
    if (row < MLAT) { const f32x4* xp = (const f32x4*)(p.out + (size_t)row * DM);
#pragma unroll
        for (int i = 0; i < 8; ++i) v[i] = xp[i * 64 + lane]; }
    while (row < MLAT) {
        const int nrow = row + stride;
        if (nrow < MLAT) { const f32x4* xq = (const f32x4*)(p.out + (size_t)nrow * DM);
#pragma unroll
            for (int i = 0; i < 8; ++i) vn[i] = xq[i * 64 + lane]; }
        f32x4* xp = (f32x4*)(p.out + (size_t)row * DM);
        float ss = 0.f;
#pragma unroll
        for (int i = 0; i < 8; ++i) ss += v[i][0] * v[i][0] + v[i][1] * v[i][1] + v[i][2] * v[i][2] + v[i][3] * v[i][3];
        ss = wave_sum(ss);
        const float rstd = rsqrtf(ss * (1.f / DM) + EPS);
#pragma unroll
        for (int i = 0; i < 8; ++i) { const int col = (i * 64 + lane) * 4; const f32x4 g = *(const f32x4*)(p.final_norm + col); xp[i * 64 + lane] = v[i] * rstd * g; }
#pragma unroll
        for (int i = 0; i < 8; ++i) v[i] = vn[i];
        row = nrow;
    }
}

__device__ void phase_rope(const Params& p, int l, unsigned char* lds) {
    const int tid = opaque_tid();
    float2* tab = (float2*)lds;
    __syncthreads();
    for (int i = tid; i < 2048; i += NTHREADS) { const int pos = i >> 5, j = i & 31; const float inv = exp2f(-(float)j * (13.287712379549449f / 32.f)); float s, c; sincosf((float)pos * inv, &s, &c); tab[i] = make_float2(c, s); }
    __syncthreads();
    bf16_t* QKVG = (bf16_t*)(p.ws + WS_R1);
    const int sub = tid & 15, grp = tid >> 4;
    const float* qn = p.qnorm_c + l * 128; const float* kn = p.knorm_c + l * 128;
    const long nlat = (long)MLAT * 4, total = nlat + (long)MCTX * 2;
    const long stride = (long)gridDim.x * 32;
    for (long id0 = (long)blockIdx.x * 32 + grp; id0 < total; id0 += 4 * stride) {
        bf16_t* ptr[4]; u32x4 w[4]; int rowv[4], slotv[4];
#pragma unroll
        for (int u = 0; u < 4; ++u) {
            const long id = id0 + u * stride; const bool ok = id < total; const long idc = ok ? id : id0;
            int row, slot; if (idc < nlat) { row = (int)(idc >> 2); const int s4 = (int)(idc & 3); slot = s4 < 2 ? 6 + s4 : 12 + s4; } else { const long j = idc - nlat; row = MLAT + (int)(j >> 1); slot = 14 + (int)(j & 1); }
            const int col = slot < 6 ? QA + slot * 128 : (slot < 8 ? KA + (slot - 6) * 128 : (slot < 14 ? QC + (slot - 8) * 128 : KC + (slot - 14) * 128));
            ptr[u] = QKVG + (size_t)row * QP + col + sub * 8; rowv[u] = row; slotv[u] = ok ? slot : -1;
            w[u] = *(const u32x4*)ptr[u];
        }
#pragma unroll
        for (int u = 0; u < 4; ++u) {
            const int row = rowv[u], slot = slotv[u];
            const bool lat = row < MLAT, isC = slot >= 8;
            float v[8];
#pragma unroll
            for (int q = 0; q < 4; ++q) { v[2 * q] = bf_lo(w[u][q]); v[2 * q + 1] = bf_hi(w[u][q]); }
            if (isC) {
                const float* gw = slot < 14 ? qn : kn;
                float ss = 0.f;
#pragma unroll
                for (int i = 0; i < 8; ++i) ss += v[i] * v[i];
                ss += xor_swz<1>(ss); ss += xor_swz<2>(ss); ss += xor_swz<4>(ss); ss += xor_swz<8>(ss);
                const float rstd = rsqrtf(ss * (1.f / 128.f) + EPS);
                const f32x4 g0 = *(const f32x4*)(gw + sub * 8), g1 = *(const f32x4*)(gw + sub * 8 + 4);
#pragma unroll
                for (int i = 0; i < 4; ++i) { v[i] = v[i] * rstd * g0[i]; v[4 + i] = v[4 + i] * rstd * g1[i]; }
            }
            float pv[8];
#pragma unroll
            for (int i = 0; i < 8; ++i) pv[i] = xor_swz<4>(v[i]);
            if (lat) {
                const int t = row & (SEQ - 1); const int pos = (sub & 8) ? (t & 63) : (t >> 6);
                const bool upper = (sub & 4) != 0; const int j0 = (sub & 3) * 8;
#pragma unroll
                for (int i = 0; i < 8; ++i) { const float2 cs = tab[pos * 32 + j0 + i]; v[i] = upper ? v[i] * cs.x + pv[i] * cs.y : v[i] * cs.x - pv[i] * cs.y; }
            }
            if (slot >= 0) { u32x4 o; o.x = cvt_pk_bf16(v[0], v[1]); o.y = cvt_pk_bf16(v[2], v[3]); o.z = cvt_pk_bf16(v[4], v[5]); o.w = cvt_pk_bf16(v[6], v[7]);
                *(u32x4*)ptr[u] = o; }
        }
    }
}

__device__ void phase_glufix(const Params& p, int l, int mrows) {
    bf16_t* Gb = (bf16_t*)(p.ws + WS_R1);
    const float* ES = (const float*)(p.ws + WS_EDGE); const float* EA = ES + (size_t)EDGE_N; const float* EU = EA + (size_t)EDGE_N;
    const float* cw = p.conv_w + (size_t)l * 3 * DFF;
    constexpr int NC4 = DFF / 4;
    const int tid = opaque_tid();
    const long total = (long)(mrows / 64) * 2 * NC4;
    for (long id = (long)blockIdx.x * NTHREADS + tid; id < total; id += (long)gridDim.x * NTHREADS) {
        const int c4 = (int)(id % NC4), be = (int)(id / NC4), blk = be >> 1, e = be & 1;
        const int sb = blk < MLAT / 64 ? (blk & 63) : ((blk - MLAT / 64) & 3), sl = blk < MLAT / 64 ? 63 : 3;
        if (e == 0 ? sb == 0 : sb == sl) continue;
        const int nb = e ? (blk + 1) * 2 : (blk - 1) * 2 + 1;
        const f32x4 s = *(const f32x4*)(ES + (size_t)be * DFF + 4 * c4), an = *(const f32x4*)(EA + (size_t)nb * DFF + 4 * c4), uu = *(const f32x4*)(EU + (size_t)be * DFF + 4 * c4);
        const f32x4 w = *(const f32x4*)(cw + (e ? 2 * DFF : 0) + 4 * c4);
        float g[4];
#pragma unroll
        for (int i = 0; i < 4; ++i) { const float v = s[i] + w[i] * an[i]; g[i] = v * __builtin_amdgcn_rcpf(1.f + __expf(-v)) * uu[i]; }
        u32x2 o; o.x = cvt_pk_bf16(g[0], g[1]); o.y = cvt_pk_bf16(g[2], g[3]);
        *(u32x2*)(Gb + (size_t)(blk * 64 + 63 * e) * DFF + 4 * c4) = o;
    }
}

__device__ void phase_attn(const Params& p, int l, unsigned char* lds, int ctr_off) {
    unsigned* ctr = (unsigned*)(p.ws + WS_CTL) + l + ctr_off;
    const int nitems = (l == DEPTH - 1) ? 1024 : 1088;
    volatile int* sh = (volatile int*)(lds + LDS_MISC);
    const bf16_t* QKVG = (const bf16_t*)(p.ws + WS_R1);
    bf16_t* O = (bf16_t*)(p.ws + WS_B + BUF1);
    float* btab = (float*)(lds + att::BTAB_OFF);
    constexpr float L2E = 1.4426950408889634f;
    { const int t0 = opaque_tid(); float2* rtab = (float2*)(lds + att::RTAB_OFF);
      __syncthreads();
      for (int i = t0; i < 2048; i += NTHREADS) { const int pos = i >> 5, j = i & 31; const float inv = exp2f(-(float)j * (13.287712379549449f / 32.f)); float s, c; sincosf((float)pos * inv, &s, &c); rtab[i] = make_float2(c, s); }
      __syncthreads(); }
    for (;;) {
        const int tid = opaque_tid();
        __syncthreads();
        if (tid == 0) sh[0] = (int)atomicAdd(ctr, 1u);
        __syncthreads();
        const int it = __builtin_amdgcn_readfirstlane(sh[0]);
        if (it >= nitems) break;
        att::Args a; a.sink_l2 = -1e30f; a.abase = 0; a.b_r0 = 0; a.b_rs0 = 0; a.qg = nullptr; a.q_rope = 0; a.q_t0 = 0;
        if (it < 768) {
            const bool isC = it < 384; const int i = isC ? it : it - 384;
            const int b = i / 96, r = i % 96, kvh = r / 48, r2 = r % 48, g = r2 >> 4, qt = r2 & 15, h = kvh * 3 + g;
            const int row0 = b * SEQ + qt * 256;
            a.ctx_row0 = MLAT + b * CTXL;
            if (isC) {
                a.Qb = QKVG + (size_t)row0 * QP + QC + h * 128; a.Kb = QKVG + KC + kvh * 128; a.Vb = QKVG + VC + kvh * 128; a.Ob = O + (size_t)row0 * DM + OC + h * 128;
                a.lat_row0 = b * SEQ; a.NT = 68; a.qg = p.qnorm_c + l * 128; a.q_rope = 1; a.q_t0 = qt * 256;
                att::attn_body<0>(a, (char*)lds);
            } else {
                const int q0 = qt * 256, ks = max(q0 - 128, 0), ke = min(q0 + 384, SEQ);
                a.Qb = QKVG + (size_t)row0 * QP + QA + h * 128; a.Kb = QKVG + KA + kvh * 128; a.Vb = QKVG + VA + kvh * 128; a.Ob = O + (size_t)row0 * DM + OA + h * 128;
                a.lat_row0 = b * SEQ + ks; a.NT = 4 + (ke - ks) / 64; a.abase = ks - q0; a.sink_l2 = p.sink_a[l * 6 + h] * L2E; a.q_rope = 1; a.q_t0 = q0;
                att::attn_body<1>(a, (char*)lds);
            }
        } else if (it < 1024) {
            const int i = it - 768, b = i >> 6, h = (i & 63) >> 4, qt = i & 15, r0 = qt * 4;
            const int rs0 = min(max(r0 - 4, 0), 56), rend = min(max(r0 - 1, 0), 56) + 8;
            const int row0 = b * SEQ + qt * 256;
            for (int k = tid; k < 15 * 31; k += NTHREADS) btab[k] = p.rpb_b[((size_t)l * 4 + h) * 465 + k] * 11.313708498984761f;
            a.ctx_row0 = MLAT + b * CTXL;
            a.Qb = QKVG + (size_t)row0 * QP + QB + h * 128; a.Kb = QKVG + KB + h * 128; a.Vb = QKVG + VB + h * 128; a.Ob = O + (size_t)row0 * DM + OB + h * 128;
            a.lat_row0 = b * SEQ + rs0 * 64; a.NT = (4 + (rend - rs0) + 1) & ~1; a.b_r0 = r0; a.b_rs0 = rs0;
            att::attn_body<2>(a, (char*)lds);
        } else {
            const int i = it - 1024, b = i >> 4, hs = i & 15;
            const int row0 = MLAT + b * CTXL;
            int qc, kc, vc, oc;
            if (hs < 6) { const int h = hs, kvh = h / 3; qc = QA + h * 128; kc = KA + kvh * 128; vc = VA + kvh * 128; oc = OA + h * 128; a.sink_l2 = p.sink_a[l * 6 + h] * L2E; }
            else if (hs < 10) { const int h = hs - 6; qc = QB + h * 128; kc = KB + h * 128; vc = VB + h * 128; oc = OB + h * 128; }
            else { const int h = hs - 10, kvh = h / 3; qc = QC + h * 128; kc = KC + kvh * 128; vc = VC + kvh * 128; oc = OC + h * 128; a.qg = p.qnorm_c + l * 128; }
            a.ctx_row0 = row0; a.lat_row0 = 0; a.NT = 4;
            a.Qb = QKVG + (size_t)row0 * QP + qc; a.Kb = QKVG + kc; a.Vb = QKVG + vc; a.Ob = O + (size_t)row0 * DM + oc;
            att::attn_body<0>(a, (char*)lds);
        }
    }
}

#define XB_TMO      128
#define XB_XCNT(j)  (256  + 64 * (j))
#define XB_XSUB(j)  (1280 + 64 * (j))
#define XB_XGEN(j)  (2304 + 64 * (j))
#define XB_TOP      3328
#define XB_TOPGEN   3392
#define XCD_BAR_WORDS 3456
#define XB_SPIN_CAP (1u << 20)
__device__ __forceinline__ unsigned xb_ld(unsigned* p)              { return __hip_atomic_load(p, __ATOMIC_RELAXED, __HIP_MEMORY_SCOPE_AGENT); }
__device__ __forceinline__ unsigned xb_add(unsigned* p, unsigned v) { return __hip_atomic_fetch_add(p, v, __ATOMIC_RELAXED, __HIP_MEMORY_SCOPE_AGENT); }
__device__ __forceinline__ unsigned xb_xcc_id() { return (unsigned)__builtin_amdgcn_s_getreg((3 << 11) | 20) & 0xFu; }
#define XB_SPIN(cond, bar) do { unsigned _sp = 0; while (cond) { __builtin_amdgcn_s_sleep(1); \
    if ((++_sp & 255u) == 0u) { if (xb_ld(&(bar)[XB_TMO])) break; if (_sp > XB_SPIN_CAP) { atomicAdd(&(bar)[XB_TMO], 1u); break; } } } } while (0)
struct XcdBarrier { unsigned* bar; unsigned x; volatile LAS unsigned* st; };
__device__ __forceinline__ XcdBarrier xcd_barrier_post(unsigned* bar, volatile LAS unsigned* st) {
    XcdBarrier b; b.bar = bar; b.x = xb_xcc_id(); b.st = st;
    if (threadIdx.x == 0) (void)xb_add(&bar[XB_XCNT(b.x)], 1u);
    return b;
}
__device__ __forceinline__ void xcd_barrier_complete(unsigned* bar, unsigned x, unsigned& nloc, unsigned& nx) {
    const unsigned G = gridDim.x * gridDim.y * gridDim.z;
    unsigned sum, cnt, mine, sp = 0u;
    for (;;) {
        sum = 0u; cnt = 0u; mine = 0u;
#pragma unroll
        for (unsigned j = 0; j < 16; ++j) { const unsigned c = xb_ld(&bar[XB_XCNT(j)]); sum += c; cnt += (c > 0u) ? 1u : 0u; mine = (j == x) ? c : mine; }
        if (sum == G) break;
        __builtin_amdgcn_s_sleep(1);
        if ((++sp & 255u) == 0u) { if (xb_ld(&bar[XB_TMO])) break; if (sp > XB_SPIN_CAP) { atomicAdd(&bar[XB_TMO], 1u); break; } }
    }
    nloc = mine > 0u ? mine : 1u; nx = cnt > 0u ? cnt : 1u;
}
__device__ __forceinline__ void xcd_barrier(const XcdBarrier& b) {
    asm volatile("s_waitcnt vmcnt(0)" ::: "memory");
    __syncthreads();
    if (threadIdx.x == 0) {
        unsigned* bar = b.bar;
        __builtin_amdgcn_s_waitcnt(0);
        unsigned nloc = b.st[0], nx = b.st[1];
        if (nloc == 0u) { xcd_barrier_complete(bar, b.x, nloc, nx); b.st[0] = nloc; b.st[1] = nx; }
        const unsigned old = xb_add(&bar[XB_XSUB(b.x)], 1u);
        const unsigned gen = old / nloc;
        if (old + 1u == (gen + 1u) * nloc) {
            __builtin_amdgcn_fence(__ATOMIC_RELEASE, "agent");
            asm volatile("s_waitcnt vmcnt(0)" ::: "memory");
            const unsigned og = xb_add(&bar[XB_TOP], 1u);
            const unsigned tg = og / nx;
            if (og + 1u == (tg + 1u) * nx) xb_add(&bar[XB_TOPGEN], 1u);
            else XB_SPIN(xb_ld(&bar[XB_TOPGEN]) == tg, bar);
            __builtin_amdgcn_fence(__ATOMIC_ACQUIRE, "agent");
            xb_add(&bar[XB_XGEN(b.x)], 1u);
            asm volatile("s_waitcnt vmcnt(0)" ::: "memory");
        } else {
            XB_SPIN(xb_ld(&bar[XB_XGEN(b.x)]) == gen, bar);
            __builtin_amdgcn_fence(__ATOMIC_ACQUIRE, "agent");
            asm volatile("s_waitcnt vmcnt(0)" ::: "memory");
        }
    }
    __syncthreads();
}

constexpr int NPHASES = 2 + 10 * DEPTH;

__device__ __forceinline__ void run_phase(const Params& p, int ph, unsigned char* shm) {
    LAS unsigned char* lds3 = (LAS unsigned char*)shm;
    bf16_t* WT = (bf16_t*)(p.ws + WS_WT);
    bf16_t* R1 = (bf16_t*)(p.ws + WS_R1);
    bf16_t* B1 = (bf16_t*)(p.ws + WS_B); bf16_t* B2 = (bf16_t*)(p.ws + WS_B + BUF1); bf16_t* B3 = (bf16_t*)(p.ws + WS_B + 2 * BUF1);
    float* xc = (float*)(p.ws + WS_XC);
    if (ph == 0) { phase_init(p, shm); return; }
    if (ph == NPHASES - 1) { phase_final(p); return; }
    const int l = (ph - 1) / 10, s = (ph - 1) % 10;
    const bool lastl = (l == DEPTH - 1);
    const int mrows = lastl ? MLAT : MTOT;
    const float* modl = (const float*)(p.ws + WS_MOD) + (size_t)l * 5 * 6 * DM;
    pg8::StaticOrder S;
    const bool upq = ((UP_I8_MASK >> l) & 1) != 0, upq_next = !lastl && ((UP_I8_MASK >> (l + 1)) & 1) != 0;
    switch (s) {
    case 0:
        if (l > 0) convert_weights(p, l, shm, upq ? (2 | 4 | 16) : (2 | 4 | 8 | 16));
        else quant_weights(p, upq);
        phase_norm(p, l, 0, MTOT, B1, l > 0, true);
        break;
    case 7: {
        float* ES = (float*)(p.ws + WS_EDGE);
        if (upq) {
            pg8::Gemm g{B1, p.ws + WS_W8UP, mrows, NUP, DM};
            pg8::EpiGLU<true> E{R1, p.conv_w + (size_t)l * 3 * DFF, p.conv_b + (size_t)l * DFF, ES, ES + EDGE_N, ES + 2 * EDGE_N, 0, (const float*)(p.ws + WS_RS), (const float*)(p.ws + WS_CSUP)};
            S.init(g.M, g.N, g.PB, gridDim.x, blockIdx.x, 0);
            pg8::gemm_phase<pg8::EpiGLU<true>, true, false>(lds3, g, S, E);
        } else {
            pg8::Gemm g{B1, WT + WT_UP, mrows, NUP, DM * 2};
            pg8::EpiGLU<false> E{R1, p.conv_w + (size_t)l * 3 * DFF, p.conv_b + (size_t)l * DFF, ES, ES + EDGE_N, ES + 2 * EDGE_N, 0, nullptr, nullptr};
            S.init(g.M, g.N, g.PB, gridDim.x, blockIdx.x, 0);
            pg8::gemm_phase<pg8::EpiGLU<false>, false, false>(lds3, g, S, E);
        }
    } break;
    case 1: {
        pg8::Gemm g{B1, p.ws + WS_W8IN, MTOT, NQ, DM};
        pg8::EpiStoreQ E{R1, QP, (const float*)(p.ws + WS_RS), (const float*)(p.ws + WS_CSIN), p.ws + WS_GATES};
        S.init(g.M, g.N, g.PB, gridDim.x, blockIdx.x, 0);
        pg8::gemm_phase<pg8::EpiStoreQ, true, false>(lds3, g, S, E);
    } break;
    case 2:
        if (!lastl) convert_weights(p, l + 1, shm, upq_next ? (1 | 8) : 1);
        phase_rope(p, l, shm); break;
    case 3:
#ifdef PROBE_ATT2
        for (int rep = 2; rep >= 0; rep -= 2) { phase_attn(p, l, shm, rep); __syncthreads(); }
#else
        phase_attn(p, l, shm, 0);
#endif
        break;
    case 4: {
        pg8::Gemm g{B2, WT + WT_BR, mrows, DM, DM * 2}; pg8::EpiBranch E{p.ws + WS_GATES, B3, 0};
        S.init(g.M, g.N, g.PB, gridDim.x, blockIdx.x, 0);
#ifdef PROBE_GEMM2
        E.dry = 1; pg8::gemm_phase<pg8::EpiBranch>(lds3, g, S, E); E.dry = 0; __syncthreads();
#endif
        pg8::gemm_phase<pg8::EpiBranch>(lds3, g, S, E);
    } break;
    case 5: case 9: {
        pg8::Gemm g; pg8::EpiResid E;
        if (s == 5) { g = pg8::Gemm{B3, WT + WT_OUT, mrows, DM, DM * 2}; E = pg8::EpiResid{p.out, xc, l == 0 ? p.x : p.out, xc, modl + 2 * DM, (float*)(p.ws + WS_PART), 0}; }
        else { g = pg8::Gemm{R1, WT + WT_DOWN, mrows, DM, DFF * 2}; E = pg8::EpiResid{p.out, xc, p.out, xc, modl + 5 * DM, (float*)(p.ws + WS_PART), 0}; }
        S.init(g.M, g.N, g.PB, gridDim.x, blockIdx.x, lastl ? 0 : MCTX / 256);
#ifdef PROBE_GEMM2
        E.dry = 1; pg8::gemm_phase<pg8::EpiResid>(lds3, g, S, E); E.dry = 0; __syncthreads();
#endif
        pg8::gemm_phase<pg8::EpiResid>(lds3, g, S, E);
    } break;
    case 6: phase_norm(p, l, 1, mrows, B1, !lastl, upq); break;
    case 8:
        if (!lastl) quant_weights(p, upq_next);
        phase_glufix(p, l, mrows); break;
    }
}

__global__ void __launch_bounds__(NTHREADS, 2) mega(Params p) {
    extern __shared__ __attribute__((aligned(16))) unsigned char shm[];
    cg::grid_group grid = cg::this_grid();
    volatile LAS unsigned* st = (volatile LAS unsigned*)((LAS unsigned char*)shm + LDS_MISC + 64);
    if (threadIdx.x == 0) { st[0] = 0u; st[1] = 0u; }
    __syncthreads();
    XcdBarrier xb{};
    if (p.coop) xb = xcd_barrier_post((unsigned*)(p.ws + WS_BAR), st);
#ifdef PROBE_REPEAT_S
    bool again = false;
#endif
    for (int ph = p.ph_lo; ph < p.ph_hi; ++ph) {
        run_phase(p, ph, shm);
        if (p.coop && ph + 1 < p.ph_hi) {
            if (p.pad == 0x5eed) grid.sync();
            else xcd_barrier(xb);
        }
#ifdef PROBE_REPEAT_S
        if (ph >= 1 && ph < NPHASES - 1 && ((ph - 1) % 10) == PROBE_REPEAT_S && !again) { again = true; --ph; } else again = false;
#endif
    }
}

extern "C" void kernel_launch(void* const* d_in, const int* in_sizes, int n_in, void* d_out, int out_size, void* d_ws, size_t ws_size, hipStream_t stream) {
    static int grid = 0;
    if (grid == 0) {
        if (n_in != 20 || ws_size < WS_END) { fprintf(stderr, "kernel_launch: unexpected n_in %d / ws %zu (need %zu)\n", n_in, ws_size, (size_t)WS_END); grid = -1; return; }
        if (hipFuncSetAttribute((const void*)mega, hipFuncAttributeMaxDynamicSharedMemorySize, LDS_BYTES) != hipSuccess) { fprintf(stderr, "kernel_launch: hipFuncSetAttribute failed\n"); grid = -1; return; }
        int dev = 0, cus = 0, per_cu = 0;
        hipGetDevice(&dev); hipDeviceGetAttribute(&cus, hipDeviceAttributeMultiprocessorCount, dev);
        if (hipOccupancyMaxActiveBlocksPerMultiprocessor(&per_cu, (const void*)mega, NTHREADS, LDS_BYTES) != hipSuccess || per_cu < 1) { fprintf(stderr, "kernel_launch: occupancy query gave %d\n", per_cu); per_cu = 1; }
        (void)hipGetLastError();
        grid = cus;
    }
    if (grid < 0) return;
    if (hipMemsetAsync((char*)d_ws + WS_CTL, 0, WS_CTL_BYTES, stream) != hipSuccess) { fprintf(stderr, "kernel_launch: memset of the control words failed\n"); return; }
    Params p{};
    const float** f = (const float**)&p;
    for (int i = 0; i < 20; ++i) f[i] = (const float*)d_in[i];
    p.out = (float*)d_out; p.ws = (unsigned char*)d_ws;
#if MK_COOP
    p.ph_lo = 0; p.ph_hi = NPHASES; p.coop = 1; p.pad = 0;
    void* args[] = {&p};
    hipError_t e = hipLaunchCooperativeKernel((const void*)mega, dim3(grid), dim3(NTHREADS), args, LDS_BYTES, stream);
    if (e != hipSuccess) fprintf(stderr, "kernel_launch: cooperative launch failed: %s (grid %d)\n", hipGetErrorString(e), grid);
#else
    for (int ph = 0; ph < NPHASES; ++ph) {
        p.ph_lo = ph; p.ph_hi = ph + 1; p.coop = 0; p.pad = 0;
        hipLaunchKernelGGL(mega, dim3(grid), dim3(NTHREADS), LDS_BYTES, stream, p);
    }
#endif
}
```

```cpp
#include <hip/hip_runtime.h>
#include <hip/hip_cooperative_groups.h>
#include <cstdio>
#include <cstdint>
namespace cg = cooperative_groups;

#ifndef MK_COOP
#define MK_COOP 1
#endif

#define LAS __attribute__((address_space(3)))
typedef unsigned short bf16_t;
typedef short bf16x8 __attribute__((ext_vector_type(8)));
typedef short s16x4 __attribute__((ext_vector_type(4)));
typedef float f32x4 __attribute__((ext_vector_type(4)));
typedef float f32x16 __attribute__((ext_vector_type(16)));
typedef unsigned u32x4 __attribute__((ext_vector_type(4)));
typedef unsigned u32x2 __attribute__((ext_vector_type(2)));
typedef int i32x4 __attribute__((ext_vector_type(4)));
#ifndef USE_SLABS
#define USE_SLABS 0
#endif
#ifndef UP_I8_MASK
#define UP_I8_MASK 1
#endif

constexpr int DM = 2048, NBATCH = 4, SEQ = 4096, CTXL = 256, DEPTH = 2;
constexpr int MLAT = NBATCH * SEQ, MCTX = NBATCH * CTXL, MTOT = MLAT + MCTX;
constexpr int NQ = 10240, DFF = 5632, NUP = 2 * DFF;
constexpr int QP = 4096;
constexpr int QA = 0, KA = 768, VA = 1024, QB = 1280, KB = 1792, VB = 2304, QC = 2816, KC = 3584, VC = 3840, GA = 4096, GB = 6144, GC = 8192;
constexpr int OA = 0, OB = 768, OC = 1280;
constexpr float EPS = 1e-6f;
constexpr int NTHREADS = 512;
constexpr int LDS_MISC = 131072, LDS_BYTES = 131072 + 2048;

constexpr size_t al256(size_t x) { return (x + 255) / 256 * 256; }
constexpr size_t WS_CTL = 0;
constexpr size_t WS_BAR = 4096;
constexpr size_t WS_CTL_BYTES = 4096 + 16384;
constexpr size_t WS_MOD = WS_CTL_BYTES;
constexpr size_t WS_XC = al256(WS_MOD + (size_t)DEPTH * 5 * 6 * DM * 4);
constexpr size_t WS_WT = al256(WS_XC + (size_t)MCTX * DM * 4);
constexpr size_t WT_IN = 0, WT_BR = WT_IN + (size_t)NQ * DM, WT_OUT = WT_BR + (size_t)DM * DM, WT_UP = WT_OUT + (size_t)DM * DM, WT_DOWN = WT_UP + (size_t)NUP * DM, WT_END = WT_DOWN + (size_t)DM * DFF;
constexpr size_t WS_R1 = al256(WS_WT + WT_END * 2);
constexpr size_t WS_GATES = WS_R1 + (size_t)MTOT * QP * 2;
constexpr size_t WS_B = al256(WS_R1 + (size_t)MTOT * NQ * 2);
constexpr size_t BUF1 = (size_t)MTOT * DM * 2;
constexpr size_t EDGE_N = (size_t)(MTOT / 64) * 2 * DFF;
constexpr size_t WS_EDGE = WS_B + BUF1;
static_assert(3 * EDGE_N * 4 <= 2 * BUF1, "edge buffers must fit B2+B3");
constexpr size_t WS_PART = al256(WS_B + 3 * BUF1);
constexpr size_t WS_W8IN = al256(WS_PART + (size_t)8 * MCTX * DM * 4);
constexpr size_t WS_W8UP = al256(WS_W8IN + (size_t)NQ * DM);
constexpr size_t WS_CSIN = al256(WS_W8UP + (size_t)NUP * DM);
constexpr size_t WS_CSUP = al256(WS_CSIN + (size_t)NQ * 4);
constexpr size_t WS_RS = al256(WS_CSUP + (size_t)NUP * 4);
constexpr size_t WS_END = WS_RS + (size_t)MTOT * 4;

struct Params {
    const float *x, *c, *ctx, *c_ctx, *w_ada, *b_ada, *norm1, *w_in, *sink_a, *rpb_b, *qnorm_c, *knorm_c, *w_branch, *w_out, *norm2, *w_up, *conv_w, *conv_b, *w_down, *final_norm;
    float* out; unsigned char* ws;
    int ph_lo, ph_hi, coop, pad;
};

__device__ __forceinline__ unsigned cvt_pk_bf16(float lo, float hi) { unsigned r; asm volatile("v_cvt_pk_bf16_f32 %0, %1, %2" : "=v"(r) : "v"(lo), "v"(hi)); return r; }
__device__ __forceinline__ float bf_lo(unsigned w) { return __uint_as_float(w << 16); }
__device__ __forceinline__ float bf_hi(unsigned w) { return __uint_as_float(w & 0xffff0000u); }
__device__ __forceinline__ int opaque_tid() { int t = threadIdx.x; asm volatile("" : "+v"(t)); return t; }
template <int X> __device__ __forceinline__ float xor_swz(float v) { return __int_as_float(__builtin_amdgcn_ds_swizzle(__float_as_int(v), (X << 10) | 0x1f)); }
__device__ __forceinline__ float wave_max(float v) {
    v = fmaxf(v, xor_swz<1>(v)); v = fmaxf(v, xor_swz<2>(v)); v = fmaxf(v, xor_swz<4>(v)); v = fmaxf(v, xor_swz<8>(v)); v = fmaxf(v, xor_swz<16>(v));
    auto rr = __builtin_amdgcn_permlane32_swap(__float_as_uint(v), __float_as_uint(v), false, false);
    return fmaxf(__uint_as_float(rr[0]), __uint_as_float(rr[1]));
}
__device__ __forceinline__ unsigned pack_i8x4(float a, float b, float c, float d) {
    const int ia = __float2int_rn(a), ib = __float2int_rn(b), ic = __float2int_rn(c), id = __float2int_rn(d);
    return (unsigned)(ia & 0xff) | ((unsigned)(ib & 0xff) << 8) | ((unsigned)(ic & 0xff) << 16) | ((unsigned)id << 24);
}
__device__ __forceinline__ float wave_sum(float v) {
    v += xor_swz<1>(v); v += xor_swz<2>(v); v += xor_swz<4>(v); v += xor_swz<8>(v); v += xor_swz<16>(v);
    auto rr = __builtin_amdgcn_permlane32_swap(__float_as_uint(v), __float_as_uint(v), false, false);
    return __uint_as_float(rr[0]) + __uint_as_float(rr[1]);
}

namespace pg8 {
#ifndef PG8_WGM
#define PG8_WGM 4
#endif
#ifndef PG8_WGM_WIDE
#define PG8_WGM_WIDE 8
#endif
constexpr int BM = 256, BK = 64, HALF = 128, HTB = HALF * BK * 2, STAGE_BYTES = 8 * HTB, NXCD = 8, WGM = PG8_WGM;
__device__ __forceinline__ int lds_byte(int r, int c) { const int st = (r >> 4) * 2 + (c >> 5), rr = r & 15, cc = c & 31, ob = rr * 64 + cc * 2; return st * 1024 + (ob ^ (((ob >> 9) & 1) << 5)); }
__device__ __forceinline__ void stage_rc(int b, int& R, int& C) { const int st = b / 1024, sb = b % 1024, swz = sb ^ (((sb >> 9) & 1) << 5); R = (st >> 1) * 16 + swz / 64; C = (st & 1) * 32 + (swz % 64) / 2; }
__device__ __forceinline__ int perm32(int rho) { const int n = rho >> 4, i = rho & 15; return 8 * (i >> 2) + 4 * n + (i & 3); }
struct Unit { int pm, pn, seg, k0, ntk, split, sl; };
struct Gemm { const void* A; const void* Bt; int M, N, PB; };
struct StaticOrder {
    int nM, nN, nwg, G, c, nMs, ntK, wgm;
    __device__ void init(int M, int N, int PB, int G_, int c_, int nMs_) { nM = M / BM - nMs_; nN = N / BM; nwg = nM * nN; G = G_; c = c_; nMs = nMs_; ntK = PB / 128; wgm = nN > 8 ? PG8_WGM_WIDE : WGM; }
    template <int SEGN> __device__ bool next(int i, Unit& u) const {
        if (SEGN > 1) { u.seg = i % SEGN; i /= SEGN; u.k0 = u.seg == 0 ? 0 : (u.seg == 1 ? 12 : 20); u.ntk = u.seg == 1 ? 8 : 12; }
        else { u.seg = 0; u.k0 = 0; u.ntk = ntK; }
        u.split = 0; u.sl = 0;
        const long L = (long)i * G + c;
        if (L < nwg) {
            int wgid = (int)L; { const int q = nwg / NXCD, r = nwg % NXCD, xcd = wgid % NXCD, off = wgid / NXCD; wgid = (xcd < r ? xcd * (q + 1) : r * (q + 1) + (xcd - r) * q) + off; }
            const int nig = wgm * nN, gid = wgid / nig, fm = gid * wgm, gsz = (nM - fm) < wgm ? (nM - fm) : wgm;
            u.pm = fm + ((wgid % nig) % gsz); u.pn = (wgid % nig) / gsz; return true;
        }
        if (SEGN > 1 || nMs == 0) return false;
        const long first = ((long)nwg + G - 1) / G * G;
        if (L < first) return false;
        const int sub = (int)(L - first), tile = sub >> 3, sl = sub & 7;
        if (tile >= nMs * nN) return false;
        u.pm = nM + tile / nN; u.pn = tile % nN; u.split = 1; u.sl = sl;
        const int pairs = ntK >> 1, base = pairs >> 3, rem = pairs & 7;
        u.ntk = 2 * (base + (sl < rem ? 1 : 0)); u.k0 = 2 * (sl * base + (sl < rem ? sl : rem));
        return true;
    }
};

struct EpiStore {
    static constexpr bool PERM = true; static constexpr int SEGN = 1;
    bf16_t* O; int ldc; int dry;
    __device__ __forceinline__ void operator()(f32x4 (&acc)[2][2][4][2], const Unit& u, int wr, int wc, int fr, int fq) const {
        if (dry) return;
        const int row0 = u.pm * BM + wr * 64 + fr, col0 = u.pn * BM + wc * 32 + 8 * fq;
#pragma unroll
        for (int ai = 0; ai < 2; ++ai)
#pragma unroll
            for (int m = 0; m < 4; ++m) { bf16_t* rowp = O + (size_t)(row0 + ai * HALF + m * 16) * ldc + col0;
#pragma unroll
                for (int bj = 0; bj < 2; ++bj) { const f32x4 v0 = acc[ai][bj][m][0], v1 = acc[ai][bj][m][1];
                    u32x4 w; w.x = cvt_pk_bf16(v0[0], v0[1]); w.y = cvt_pk_bf16(v0[2], v0[3]); w.z = cvt_pk_bf16(v1[0], v1[1]); w.w = cvt_pk_bf16(v1[2], v1[3]);
                    *(u32x4*)(rowp + bj * HALF) = w; } }
    }
};
struct EpiStoreQ {
    static constexpr bool PERM = true; static constexpr int SEGN = 1;
    bf16_t* O; int ldc; const float* rs; const float* cs; unsigned char* gt;
    __device__ __forceinline__ void operator()(f32x4 (&acc)[2][2][4][2], const Unit& u, int wr, int wc, int fr, int fq) const {
        const int row0 = u.pm * BM + wr * 64 + fr, col0 = u.pn * BM + wc * 32 + 8 * fq;
        const bool gate_tile = u.pn >= QP / BM;
        unsigned char* gbase = gt + ((size_t)((((u.pn - QP / BM) >> 3) * (MTOT / BM) + u.pm) * 8 + ((u.pn - QP / BM) & 7)) << 17) + (size_t)((((wr * 4 + wc) << 6) + fq * 16 + fr) * 16);
        f32x4 cv[2][2];
#pragma unroll
        for (int bj = 0; bj < 2; ++bj)
#pragma unroll
            for (int n = 0; n < 2; ++n) cv[bj][n] = *(const f32x4*)(cs + col0 + bj * HALF + 4 * n);
#pragma unroll
        for (int ai = 0; ai < 2; ++ai)
#pragma unroll
            for (int m = 0; m < 4; ++m) { const int row = row0 + ai * HALF + m * 16; const float r = rs[row]; bf16_t* rowp = O + (size_t)row * ldc + col0;
#pragma unroll
                for (int bj = 0; bj < 2; ++bj) { const i32x4 i0 = __builtin_bit_cast(i32x4, acc[ai][bj][m][0]), i1 = __builtin_bit_cast(i32x4, acc[ai][bj][m][1]);
                    float v[8];
#pragma unroll
                    for (int j = 0; j < 4; ++j) { v[j] = (float)i0[j] * r * cv[bj][0][j]; v[4 + j] = (float)i1[j] * r * cv[bj][1][j]; }
                    u32x4 w; w.x = cvt_pk_bf16(v[0], v[1]); w.y = cvt_pk_bf16(v[2], v[3]); w.z = cvt_pk_bf16(v[4], v[5]); w.w = cvt_pk_bf16(v[6], v[7]);
                    if (gate_tile) *(u32x4*)(gbase + ((ai * 2 + bj) * 4 + m) * 8192) = w;
                    else *(u32x4*)(rowp + bj * HALF) = w; } }
    }
};
struct EpiResid {
    static constexpr bool PERM = false; static constexpr int SEGN = 1;
    float* xlat; float* xctx; const float* slat; const float* sctx; const float* modv; float* part; int dry;
    __device__ __forceinline__ void operator()(f32x4 (&acc)[2][2][4][2], const Unit& u, int wr, int wc, int fr, int fq) const {
        if (dry) return;
        const int set = u.pm < (MLAT / BM) ? (u.pm >> 4) : 4;
        float* xb = u.pm < (MLAT / BM) ? xlat + (size_t)u.pm * BM * DM : xctx + (size_t)(u.pm - MLAT / BM) * BM * DM;
        const float* sb = u.pm < (MLAT / BM) ? slat + (size_t)u.pm * BM * DM : sctx + (size_t)(u.pm - MLAT / BM) * BM * DM;
        float* pp = part + ((size_t)u.sl * MCTX + (size_t)(u.pm - MLAT / BM) * BM) * DM;
        const int col0 = u.pn * BM + wc * 32 + 4 * fq;
        const float* mp = modv + (size_t)set * 6 * DM + col0;
        f32x4 mv[2][2];
#pragma unroll
        for (int bj = 0; bj < 2; ++bj)
#pragma unroll
            for (int n = 0; n < 2; ++n) mv[bj][n] = *(const f32x4*)(mp + bj * HALF + n * 16);
        if (u.split) {
#pragma unroll
            for (int ai = 0; ai < 2; ++ai)
#pragma unroll
                for (int m = 0; m < 4; ++m) { const size_t ro = (size_t)(ai * HALF + wr * 64 + m * 16 + fr) * DM + col0;
#pragma unroll
                    for (int bj = 0; bj < 2; ++bj)
#pragma unroll
                        for (int n = 0; n < 2; ++n) *(f32x4*)(pp + ro + bj * HALF + n * 16) = mv[bj][n] * acc[ai][bj][m][n]; }
            return;
        }
#pragma unroll
        for (int ai = 0; ai < 2; ++ai) {
            f32x4 xv[4][2][2];
#pragma unroll
            for (int m = 0; m < 4; ++m) { const float* srcp = sb + (size_t)(ai * HALF + wr * 64 + m * 16 + fr) * DM + col0;
#pragma unroll
                for (int bj = 0; bj < 2; ++bj)
#pragma unroll
                    for (int n = 0; n < 2; ++n) xv[m][bj][n] = *(const f32x4*)(srcp + bj * HALF + n * 16); }
#pragma unroll
            for (int m = 0; m < 4; ++m) { float* rowp = xb + (size_t)(ai * HALF + wr * 64 + m * 16 + fr) * DM + col0;
#pragma unroll
                for (int bj = 0; bj < 2; ++bj)
#pragma unroll
                    for (int n = 0; n < 2; ++n) *(f32x4*)(rowp + bj * HALF + n * 16) = xv[m][bj][n] + mv[bj][n] * acc[ai][bj][m][n]; }
            asm volatile("" ::: "memory"); }
    }
};
struct EpiBranch {
    static constexpr bool PERM = true; static constexpr int SEGN = 3;
    const unsigned char* gt; bf16_t* O; int dry;
    __device__ __forceinline__ const unsigned char* gtile(int g, const Unit& u, int wr, int wc, int fr, int fq) const { return gt + ((size_t)((g * (MTOT / BM) + u.pm) * 8 + u.pn) << 17) + (size_t)((((wr * 4 + wc) << 6) + fq * 16 + fr) * 16); }
    __device__ __forceinline__ void rescale(f32x4 (&acc)[2][2][4][2], const Unit& u, int which, int wr, int wc, int fr, int fq) const {
        const unsigned char* p1 = gtile(which, u, wr, wc, fr, fq); const unsigned char* p2 = gtile(which + 1, u, wr, wc, fr, fq);
#pragma unroll
        for (int ai = 0; ai < 2; ++ai) {
            u32x4 g1v[4][2], g2v[4][2];
#pragma unroll
            for (int m = 0; m < 4; ++m) {
#pragma unroll
                for (int bj = 0; bj < 2; ++bj) { g1v[m][bj] = *(const u32x4*)(p1 + ((ai * 2 + bj) * 4 + m) * 8192); g2v[m][bj] = *(const u32x4*)(p2 + ((ai * 2 + bj) * 4 + m) * 8192); } }
#pragma unroll
            for (int m = 0; m < 4; ++m) {
#pragma unroll
                for (int bj = 0; bj < 2; ++bj) { const u32x4 g1 = g1v[m][bj], g2 = g2v[m][bj];
#pragma unroll
                    for (int q = 0; q < 4; ++q) { const float a0 = bf_lo(g1[q]), a1 = bf_hi(g1[q]), b0 = bf_lo(g2[q]), b1 = bf_hi(g2[q]);
                        const float r0 = (1.f + __expf(-b0)) * __builtin_amdgcn_rcpf(1.f + __expf(-a0)), r1 = (1.f + __expf(-b1)) * __builtin_amdgcn_rcpf(1.f + __expf(-a1));
                        acc[ai][bj][m][q >> 1][(q & 1) * 2] *= r0; acc[ai][bj][m][q >> 1][(q & 1) * 2 + 1] *= r1; } } }
            asm volatile("" ::: "memory"); }
    }
    __device__ __forceinline__ void operator()(f32x4 (&acc)[2][2][4][2], const Unit& u, int wr, int wc, int fr, int fq) const {
        if (dry) return;
        if (u.seg < 2) { rescale(acc, u, u.seg, wr, wc, fr, fq); return; }
        const int row0 = u.pm * BM + wr * 64 + fr, col0 = u.pn * BM + wc * 32 + 8 * fq;
        const unsigned char* p3 = gtile(2, u, wr, wc, fr, fq);
#pragma unroll
        for (int ai = 0; ai < 2; ++ai) {
            u32x4 gv[4][2];
#pragma unroll
            for (int m = 0; m < 4; ++m) {
#pragma unroll
                for (int bj = 0; bj < 2; ++bj) gv[m][bj] = *(const u32x4*)(p3 + ((ai * 2 + bj) * 4 + m) * 8192); }
#pragma unroll
            for (int m = 0; m < 4; ++m) { bf16_t* rowp = O + (size_t)(row0 + ai * HALF + m * 16) * DM + col0;
#pragma unroll
                for (int bj = 0; bj < 2; ++bj) { const u32x4 g = gv[m][bj]; float v[8];
#pragma unroll
                    for (int q = 0; q < 4; ++q) { const float s0 = __builtin_amdgcn_rcpf(1.f + __expf(-bf_lo(g[q]))), s1 = __builtin_amdgcn_rcpf(1.f + __expf(-bf_hi(g[q])));
                        v[2 * q] = acc[ai][bj][m][q >> 1][(q & 1) * 2] * s0; v[2 * q + 1] = acc[ai][bj][m][q >> 1][(q & 1) * 2 + 1] * s1; }
                    u32x4 w; w.x = cvt_pk_bf16(v[0], v[1]); w.y = cvt_pk_bf16(v[2], v[3]); w.z = cvt_pk_bf16(v[4], v[5]); w.w = cvt_pk_bf16(v[6], v[7]);
                    *(u32x4*)(rowp + bj * HALF) = w; } }
            asm volatile("" ::: "memory"); }
    }
};

template <int CTRL> __device__ __forceinline__ float dppf(float x) { return __int_as_float(__builtin_amdgcn_update_dpp(0, __float_as_int(x), CTRL, 0xf, 0xf, false)); }
template <bool Q> struct EpiGLU {
    static constexpr bool PERM = true; static constexpr int SEGN = 1;
    bf16_t* G; const float* cw; const float* cb; float* ES; float* EA; float* EU; int dry; const float* rs; const float* cs;
    __device__ __forceinline__ void operator()(f32x4 (&acc)[2][2][4][2], const Unit& u, int wr, int wc, int fr, int fq) const {
        if (dry) return;
        const int colg = u.pn * 128 + wc * 32 + 8 * fq;
        if constexpr (Q) {
            const int ct = u.pn * BM + wc * 32 + 8 * fq;
            f32x4 cv[2][2];
#pragma unroll
            for (int bj = 0; bj < 2; ++bj)
#pragma unroll
                for (int n = 0; n < 2; ++n) cv[bj][n] = *(const f32x4*)(cs + ct + bj * HALF + 4 * n);
#pragma unroll
            for (int ai = 0; ai < 2; ++ai)
#pragma unroll
                for (int m = 0; m < 4; ++m) { const float r = rs[u.pm * BM + ai * HALF + wr * 64 + m * 16 + fr];
#pragma unroll
                    for (int bj = 0; bj < 2; ++bj)
#pragma unroll
                        for (int n = 0; n < 2; ++n) { const i32x4 iv = __builtin_bit_cast(i32x4, acc[ai][bj][m][n]);
#pragma unroll
                            for (int j = 0; j < 4; ++j) acc[ai][bj][m][n][j] = (float)iv[j] * r * cv[bj][n][j]; } }
        }
        float w0[8], w1[8], w2[8], bb[8];
#pragma unroll
        for (int h = 0; h < 2; ++h) { const f32x4 a0 = *(const f32x4*)(cw + colg + 4 * h), a1 = *(const f32x4*)(cw + DFF + colg + 4 * h), a2 = *(const f32x4*)(cw + 2 * DFF + colg + 4 * h), a3 = *(const f32x4*)(cb + colg + 4 * h);
#pragma unroll
            for (int i = 0; i < 4; ++i) { w0[4 * h + i] = a0[i]; w1[4 * h + i] = a1[i]; w2[4 * h + i] = a2[i]; bb[4 * h + i] = a3[i]; } }
#pragma unroll
        for (int ai = 0; ai < 2; ++ai) {
            const int blk = 4 * u.pm + 2 * ai + wr;
#pragma unroll
            for (int m = 0; m < 4; ++m) {
                float g[8], sv[8];
#pragma unroll
                for (int e = 0; e < 8; ++e) { const int n = e >> 2, j = e & 3;
                    const float a = acc[ai][0][m][n][j], uu = acc[ai][1][m][n][j];
                    const float tp = (m > 0 && fr == 15) ? acc[ai][0][m > 0 ? m - 1 : 0][n][j] : a;
                    const float tn = (m < 3 && fr == 0) ? acc[ai][0][m < 3 ? m + 1 : 3][n][j] : a;
                    float prev = dppf<0x121>(tp), next = dppf<0x12F>(tn);
                    if (m == 0 && fr == 0) prev = 0.f;
                    if (m == 3 && fr == 15) next = 0.f;
                    const float v = w0[e] * prev + w1[e] * a + w2[e] * next + bb[e];
                    sv[e] = v; g[e] = v * __builtin_amdgcn_rcpf(1.f + __expf(-v)) * uu; }
                const int row = u.pm * BM + ai * HALF + wr * 64 + m * 16 + fr;
                u32x4 w; w.x = cvt_pk_bf16(g[0], g[1]); w.y = cvt_pk_bf16(g[2], g[3]); w.z = cvt_pk_bf16(g[4], g[5]); w.w = cvt_pk_bf16(g[6], g[7]);
                *(u32x4*)(G + (size_t)row * DFF + colg) = w;
                if ((m == 0 && fr == 0) || (m == 3 && fr == 15)) {
                    const size_t eo = ((size_t)blk * 2 + (m == 0 ? 0 : 1)) * DFF + colg;
#pragma unroll
                    for (int h = 0; h < 2; ++h) {
                        *(f32x4*)(ES + eo + 4 * h) = (f32x4){sv[4 * h], sv[4 * h + 1], sv[4 * h + 2], sv[4 * h + 3]};
                        *(f32x4*)(EA + eo + 4 * h) = acc[ai][0][m][h];
                        *(f32x4*)(EU + eo + 4 * h) = acc[ai][1][m][h]; }
                }
                asm volatile("" ::: "memory");
            }
        }
    }
};

#ifndef PG8_SP2
#define PG8_SP2 true
#endif
#ifndef PG8_ALIGN
#define PG8_ALIGN true
#endif
template <class Epi, bool I8 = false, bool ALIGN_EPI = PG8_ALIGN, bool SP2 = PG8_SP2>
__device__ __forceinline__ void gemm_phase(LAS unsigned char* lds, const Gemm g, const StaticOrder& S, const Epi& E) {
    const int tid = opaque_tid(), wid = __builtin_amdgcn_readfirstlane(tid >> 6), lane = tid & 63, wr = wid >> 2, wc = wid & 3, fr = lane & 15, fq = lane >> 4;
    const int PB = g.PB;
    unsigned voffA[2], voffB[2];
#pragma unroll
    for (int i = 0; i < 2; ++i) { int R, C; stage_rc(tid * 16 + i * 8192, R, C); const int Rb = Epi::PERM ? ((R & ~31) + perm32(R & 31)) : R;
        voffA[i] = (unsigned)(R * PB + C * 2); voffB[i] = (unsigned)(Rb * PB + C * 2); }
    const size_t kstep = (size_t)(BK * 2);
    const size_t hstep = (size_t)HALF * PB;
    const size_t tstep = 2 * hstep;
    const unsigned ldsw = (unsigned)wid * 1024u;
    const int aoff = lds_byte(wr * 64 + fr, fq * 8), boff = lds_byte(wc * 32 + fr, fq * 8);
#define PG8_SA(b, h) (((b) * 2 + (h)) * HTB)
#define PG8_SB(b, h) ((4 + (b) * 2 + (h)) * HTB)
#define PG8_STAGE(bufoff, gbase, voff) do { _Pragma("unroll") for (int _i = 0; _i < 2; ++_i) \
        __builtin_amdgcn_global_load_lds((const unsigned*)((const char*)(gbase) + (voff)[_i]), (LAS unsigned*)(lds + (bufoff) + ldsw + _i * 8192), 16, 0, 0); } while (0)
#define PG8_LDA(dst, b, h) do { _Pragma("unroll") for (int m = 0; m < 4; ++m) _Pragma("unroll") for (int k = 0; k < 2; ++k) dst[m][k] = *(const LAS bf16x8*)(lds + PG8_SA(b, h) + aoff + m * 2048 + k * 1024); } while (0)
#define PG8_LDB(dst, b, h) do { _Pragma("unroll") for (int n = 0; n < 2; ++n) _Pragma("unroll") for (int k = 0; k < 2; ++k) dst[n][k] = *(const LAS bf16x8*)(lds + PG8_SB(b, h) + boff + n * 2048 + k * 1024); } while (0)
#define PG8_MMA(ai, bj, At, Bt) do { __builtin_amdgcn_s_setprio(1); _Pragma("unroll") for (int m = 0; m < 4; ++m) _Pragma("unroll") for (int n = 0; n < 2; ++n) _Pragma("unroll") for (int k = 0; k < 2; ++k) \
        { if constexpr (I8) acc[ai][bj][m][n] = __builtin_bit_cast(f32x4, __builtin_amdgcn_mfma_i32_16x16x64_i8(__builtin_bit_cast(i32x4, Bt[n][k]), __builtin_bit_cast(i32x4, At[m][k]), __builtin_bit_cast(i32x4, acc[ai][bj][m][n]), 0, 0, 0)); \
          else acc[ai][bj][m][n] = __builtin_amdgcn_mfma_f32_16x16x32_bf16(Bt[n][k], At[m][k], acc[ai][bj][m][n], 0, 0, 0); } __builtin_amdgcn_s_setprio(0); } while (0)
#define PG8_WAIT_V(n) asm volatile("s_waitcnt vmcnt(" #n ")" ::: "memory")
#define PG8_WAIT_L(n) asm volatile("s_waitcnt lgkmcnt(" #n ")" ::: "memory")
#define PG8_BAR __builtin_amdgcn_s_barrier()
#define PG8_SCHED __builtin_amdgcn_sched_barrier(0)
    constexpr int SEGN = Epi::SEGN;
    Unit cur, nxt; int ui = 0;
    if (!S.template next<SEGN>(0, cur)) return;
    f32x4 acc[2][2][4][2];
#pragma unroll
    for (int a = 0; a < 2; ++a)
#pragma unroll
        for (int b = 0; b < 2; ++b)
#pragma unroll
            for (int m = 0; m < 4; ++m)
#pragma unroll
                for (int n = 0; n < 2; ++n) acc[a][b][m][n] = (f32x4){0.f, 0.f, 0.f, 0.f};
    bf16x8 At[4][2], B0[2][2], B1[2][2];
    const char* cA = (const char*)g.A + (size_t)cur.pm * tstep + (size_t)cur.k0 * kstep; const char* cB = (const char*)g.Bt + (size_t)cur.pn * tstep + (size_t)cur.k0 * kstep;
    if constexpr (SP2) {
        PG8_STAGE(PG8_SB(0, 0), cB, voffB); PG8_STAGE(PG8_SB(0, 1), cB + hstep, voffB); PG8_STAGE(PG8_SA(0, 0), cA, voffA); PG8_STAGE(PG8_SA(0, 1), cA + hstep, voffA);
        if (wr == 1) PG8_BAR;
        PG8_WAIT_V(2); PG8_BAR;
        PG8_STAGE(PG8_SB(1, 0), cB + kstep, voffB); PG8_STAGE(PG8_SA(1, 0), cA + kstep, voffA); PG8_STAGE(PG8_SB(1, 1), cB + hstep + kstep, voffB);
        PG8_WAIT_V(6); PG8_BAR;
    } else {
    PG8_STAGE(PG8_SB(0, 0), cB, voffB); PG8_STAGE(PG8_SA(0, 0), cA, voffA); PG8_STAGE(PG8_SB(0, 1), cB + hstep, voffB); PG8_STAGE(PG8_SA(0, 1), cA + hstep, voffA);
    if (wr == 1) PG8_BAR;
    PG8_WAIT_V(4); PG8_BAR;
    PG8_STAGE(PG8_SB(1, 0), cB + kstep, voffB); PG8_STAGE(PG8_SA(1, 0), cA + kstep, voffA); PG8_STAGE(PG8_SB(1, 1), cB + hstep + kstep, voffB);
    PG8_WAIT_V(6); PG8_BAR;
    }
    for (;;) {
        const bool has_next = S.template next<SEGN>(ui + 1, nxt);
        const char* nA = has_next ? (const char*)g.A + (size_t)nxt.pm * tstep + (size_t)nxt.k0 * kstep : cA; const char* nB = has_next ? (const char*)g.Bt + (size_t)nxt.pn * tstep + (size_t)nxt.k0 * kstep : cB;
        const int ntc = cur.ntk;
        for (int t = 0; t < ntc; t += 2) {
            const bool last = (t == ntc - 2);
            const char* a1 = cA + (size_t)(t + 1) * kstep;
            const char* a2 = last ? nA : cA + (size_t)(t + 2) * kstep; const char* b2 = last ? nB : cB + (size_t)(t + 2) * kstep;
            const char* a3 = a2 + kstep; const char* b3 = b2 + kstep;
            if constexpr (SP2) {
            PG8_LDB(B0, 0, 0); PG8_LDB(B1, 0, 1); PG8_SCHED; PG8_LDA(At, 0, 0); PG8_STAGE(PG8_SA(1, 1), a1 + hstep, voffA);
            PG8_WAIT_V(8); PG8_WAIT_L(0); PG8_BAR; PG8_MMA(0, 0, At, B0); PG8_MMA(0, 1, At, B1); PG8_BAR; PG8_SCHED;
            PG8_LDA(At, 0, 1); PG8_STAGE(PG8_SB(0, 0), b2, voffB); PG8_STAGE(PG8_SB(0, 1), b2 + hstep, voffB); PG8_STAGE(PG8_SA(0, 0), a2, voffA);
            PG8_WAIT_V(8); PG8_WAIT_L(0); PG8_BAR; PG8_MMA(1, 0, At, B0); PG8_MMA(1, 1, At, B1); PG8_BAR; PG8_SCHED;
            PG8_LDB(B0, 1, 0); PG8_LDB(B1, 1, 1); PG8_SCHED; PG8_LDA(At, 1, 0); PG8_STAGE(PG8_SA(0, 1), a2 + hstep, voffA);
            PG8_WAIT_V(8); PG8_WAIT_L(0); PG8_BAR; PG8_MMA(0, 0, At, B0); PG8_MMA(0, 1, At, B1); PG8_BAR; PG8_SCHED;
            PG8_LDA(At, 1, 1); PG8_STAGE(PG8_SB(1, 0), b3, voffB); PG8_STAGE(PG8_SB(1, 1), b3 + hstep, voffB); PG8_STAGE(PG8_SA(1, 0), a3, voffA);
            PG8_WAIT_V(8); PG8_WAIT_L(0); PG8_BAR; PG8_MMA(1, 0, At, B0); PG8_MMA(1, 1, At, B1); PG8_BAR; PG8_SCHED;
            } else {
            PG8_LDB(B0, 0, 0); PG8_SCHED; PG8_LDA(At, 0, 0); PG8_STAGE(PG8_SA(1, 1), a1 + hstep, voffA);
            PG8_WAIT_L(8); PG8_BAR; PG8_WAIT_L(0); PG8_MMA(0, 0, At, B0); PG8_BAR; PG8_SCHED;
            PG8_LDB(B1, 0, 1); PG8_STAGE(PG8_SB(0, 0), b2, voffB);
            PG8_BAR; PG8_WAIT_L(0); PG8_MMA(0, 1, At, B1); PG8_BAR;
            PG8_LDA(At, 0, 1); PG8_STAGE(PG8_SA(0, 0), a2, voffA);
            PG8_BAR; PG8_WAIT_L(0); PG8_MMA(1, 0, At, B0); PG8_BAR; PG8_SCHED;
            PG8_STAGE(PG8_SB(0, 1), b2 + hstep, voffB);
            PG8_WAIT_V(6); PG8_BAR; PG8_MMA(1, 1, At, B1); PG8_BAR;
            PG8_LDB(B0, 1, 0); PG8_SCHED; PG8_LDA(At, 1, 0); PG8_STAGE(PG8_SA(0, 1), a2 + hstep, voffA);
            PG8_WAIT_L(8); PG8_BAR; PG8_WAIT_L(0); PG8_MMA(0, 0, At, B0); PG8_BAR; PG8_SCHED;
            PG8_LDB(B1, 1, 1); PG8_STAGE(PG8_SB(1, 0), b3, voffB);
            PG8_BAR; PG8_WAIT_L(0); PG8_MMA(0, 1, At, B1); PG8_BAR;
            PG8_LDA(At, 1, 1); PG8_STAGE(PG8_SA(1, 0), a3, voffA);
            PG8_BAR; PG8_WAIT_L(0); PG8_MMA(1, 0, At, B0); PG8_BAR; PG8_SCHED;
            PG8_STAGE(PG8_SB(1, 1), b3 + hstep, voffB);
            PG8_WAIT_V(6); PG8_BAR; PG8_MMA(1, 1, At, B1); PG8_BAR;
            }
        }
        if constexpr (ALIGN_EPI) { if (wr == 0) PG8_BAR; }
        E(acc, cur, wr, wc, fr, fq);
        if (!has_next) break;
        if (SEGN == 1 || cur.seg == SEGN - 1) {
#pragma unroll
        for (int a = 0; a < 2; ++a)
#pragma unroll
            for (int b = 0; b < 2; ++b)
#pragma unroll
                for (int m = 0; m < 4; ++m)
#pragma unroll
                    for (int n = 0; n < 2; ++n) acc[a][b][m][n] = (f32x4){0.f, 0.f, 0.f, 0.f};
        }
        cur = nxt; cA = nA; cB = nB; ++ui;
        if constexpr (ALIGN_EPI) { if (wr == 1) PG8_BAR; }
    }
    PG8_WAIT_V(0);
    if constexpr (!ALIGN_EPI) { if (wr == 0) PG8_BAR; }
    PG8_BAR;
#undef PG8_SA
#undef PG8_SB
#undef PG8_STAGE
#undef PG8_LDA
#undef PG8_LDB
#undef PG8_MMA
#undef PG8_WAIT_V
#undef PG8_WAIT_L
#undef PG8_BAR
#undef PG8_SCHED
}
}

namespace att {
constexpr int D = 128, NW = 8, QBLK = 32, KVBLK = 64;
constexpr float SCALE = 0.088388347648318440f;
constexpr float THR = 8.f;
#ifndef ATT_SDEPTH
#define ATT_SDEPTH 1
#endif
constexpr int SDEPTH = ATT_SDEPTH;
constexpr int LDQ = QP, LDK = QP, LDO = DM;
constexpr size_t SHM_V = KVBLK * D * 2, SHM_K = KVBLK * D * 2, SHM_ATTN = 2 * SHM_V + 2 * SHM_K + NW * 64 * 4;
constexpr int BTAB_OFF = (int)SHM_ATTN;
constexpr int RTAB_OFF = BTAB_OFF + 2048;
#define KSWZ(row, colB) ((row) * 256 + ((colB) ^ (((row) & 7) << 4)))
#define SBAR() __builtin_amdgcn_sched_barrier(0)
__device__ __forceinline__ int crow(int r, int hi) { return (r & 3) + 8 * (r >> 2) + 4 * hi; }

struct Args {
    const bf16_t* Qb;
    const bf16_t* Kb;
    const bf16_t* Vb;
    bf16_t* Ob;
    int ctx_row0, lat_row0, NT;
    float sink_l2;
    int abase;
    int b_r0, b_rs0;
    const float* qg;
    int q_rope, q_t0;
};

__device__ __forceinline__ void partialSM(f32x16& p0, f32x16& p1, float& m_reg, float& mn, float& alpha) {
    constexpr float C = SCALE * 1.4426950408889634f;
    float pmax = p0[0];
#pragma unroll
    for (int r = 1; r < 16; ++r) pmax = fmaxf(pmax, p0[r]);
#pragma unroll
    for (int r = 0; r < 16; ++r) pmax = fmaxf(pmax, p1[r]);
    { auto rr = __builtin_amdgcn_permlane32_swap(__float_as_uint(pmax), __float_as_uint(pmax), false, false);
      pmax = fmaxf(__uint_as_float(rr[0]), __uint_as_float(rr[1])); }
    if (__builtin_expect(__all(pmax - m_reg <= THR / SCALE), 1)) { mn = m_reg; alpha = 1.f; }
    else { mn = fmaxf(m_reg, pmax); alpha = __builtin_amdgcn_exp2f((m_reg - mn) * C); m_reg = mn; }
    float mnC = -mn * C;
#pragma unroll
    for (int r = 0; r < 16; ++r) p0[r] = fmaf(p0[r], C, mnC);
#pragma unroll
    for (int r = 0; r < 16; ++r) p1[r] = fmaf(p1[r], C, mnC);
#pragma unroll
    for (int r = 0; r < 16; ++r) p0[r] = __builtin_amdgcn_exp2f(p0[r]);
}
__device__ __forceinline__ void finishSM(f32x16& p0, f32x16& p1, float alpha, float& l_reg, bf16x8& pa0, bf16x8& pa1, bf16x8& pa2, bf16x8& pa3) {
#pragma unroll
    for (int r = 0; r < 16; ++r) p1[r] = __builtin_amdgcn_exp2f(p1[r]);
    float ps = 0;
#pragma unroll
    for (int r = 0; r < 16; ++r) ps += p0[r];
#pragma unroll
    for (int r = 0; r < 16; ++r) ps += p1[r];
    { auto rr = __builtin_amdgcn_permlane32_swap(__float_as_uint(ps), __float_as_uint(ps), false, false);
      ps = __uint_as_float(rr[0]) + __uint_as_float(rr[1]); }
    l_reg = l_reg * alpha + ps;
#define PK4(P, BASE, OUT) do { unsigned a0 = cvt_pk_bf16(P[BASE + 0], P[BASE + 1]), a1 = cvt_pk_bf16(P[BASE + 2], P[BASE + 3]);   \
    unsigned b0 = cvt_pk_bf16(P[BASE + 4], P[BASE + 5]), b1 = cvt_pk_bf16(P[BASE + 6], P[BASE + 7]);                              \
    auto r0 = __builtin_amdgcn_permlane32_swap(a0, b0, false, false); auto r1 = __builtin_amdgcn_permlane32_swap(a1, b1, false, false); \
    u32x4 w = {r0[0], r1[0], r0[1], r1[1]}; OUT = *reinterpret_cast<bf16x8*>(&w); } while (0)
    PK4(p0, 0, pa0); PK4(p0, 8, pa1); PK4(p1, 0, pa2); PK4(p1, 8, pa3);
#undef PK4
}
__device__ __forceinline__ void qkt(f32x16& p0, f32x16& p1, const char* Ks, const bf16x8* qr, int r32, int hi) {
    p0 = f32x16{}; p1 = f32x16{};
#pragma unroll
    for (int d0 = 0; d0 < 8; ++d0) { int cb = (d0 * 16 + hi * 8) * 2;
        bf16x8 b0 = *reinterpret_cast<const bf16x8*>(Ks + KSWZ(r32, cb));
        bf16x8 b1 = *reinterpret_cast<const bf16x8*>(Ks + KSWZ(32 + r32, cb));
        p0 = __builtin_amdgcn_mfma_f32_32x32x16_bf16(b0, qr[d0], p0, 0, 0, 0);
        p1 = __builtin_amdgcn_mfma_f32_32x32x16_bf16(b1, qr[d0], p1, 0, 0, 0); }
}
__device__ __forceinline__ int v_st(int k, int c) { const int kk = (k & ~0xC) | ((k & 4) << 1) | ((k & 8) >> 1); return ((kk >> 3) * 4 + (c >> 5)) * 512 + ((kk & 7) * 32 + (c & 31)) * 2; }
__device__ __forceinline__ int v_rd_base(int lane) { return ((lane & 3) << 3) | (((lane >> 2) & 3) << 6) | (((lane >> 4) & 1) << 5) | (((lane >> 5) & 1) << 8); }
constexpr int v_rd_off(int d0, int ks, int half) { return d0 * 512 + ks * 4096 + half * 2048; }
template <int OFF> __device__ __forceinline__ s16x4 tr_read(int vb) {
    s16x4 r; asm volatile("ds_read_b64_tr_b16 %0, %1 offset:%2" : "=&v"(r) : "v"(vb), "i"(OFF) : "memory"); return r;
}
template <int D0> __device__ __forceinline__ void pv_one(f32x16& od, int vb, bf16x8 pa0, bf16x8 pa1, bf16x8 pa2, bf16x8 pa3) {
    const s16x4 l0 = tr_read<v_rd_off(D0, 0, 0)>(vb), h0 = tr_read<v_rd_off(D0, 0, 1)>(vb), l1 = tr_read<v_rd_off(D0, 1, 0)>(vb), h1 = tr_read<v_rd_off(D0, 1, 1)>(vb);
    const s16x4 l2 = tr_read<v_rd_off(D0, 2, 0)>(vb), h2 = tr_read<v_rd_off(D0, 2, 1)>(vb), l3 = tr_read<v_rd_off(D0, 3, 0)>(vb), h3 = tr_read<v_rd_off(D0, 3, 1)>(vb);
    asm volatile("s_waitcnt lgkmcnt(0)" ::: "memory"); SBAR();
#define PK(L, H) (bf16x8){L[0], L[1], L[2], L[3], H[0], H[1], H[2], H[3]}
    od = __builtin_amdgcn_mfma_f32_32x32x16_bf16(pa0, PK(l0, h0), od, 0, 0, 0);
    od = __builtin_amdgcn_mfma_f32_32x32x16_bf16(pa1, PK(l1, h1), od, 0, 0, 0);
    od = __builtin_amdgcn_mfma_f32_32x32x16_bf16(pa2, PK(l2, h2), od, 0, 0, 0);
    od = __builtin_amdgcn_mfma_f32_32x32x16_bf16(pa3, PK(l3, h3), od, 0, 0, 0);
#undef PK
}
__device__ __forceinline__ void pv_d0(f32x16* o, int vb, bf16x8 pa0, bf16x8 pa1, bf16x8 pa2, bf16x8 pa3) {
    pv_one<0>(o[0], vb, pa0, pa1, pa2, pa3); pv_one<1>(o[1], vb, pa0, pa1, pa2, pa3); pv_one<2>(o[2], vb, pa0, pa1, pa2, pa3); pv_one<3>(o[3], vb, pa0, pa1, pa2, pa3);
}

#ifndef SKIP_A
#define SKIP_A 1
#endif
#ifndef SKIP_B
#define SKIP_B 0
#endif
template <int MODE>
__device__ __forceinline__ void apply_mask(f32x16& p0, f32x16& p1, int j, const Args& a, int wid, int r32, int hi, const float* btab) {
    if constexpr (MODE == 1) {
        if (j >= 4) {
            const int baseW = a.abase + 64 * (j - 4) - 32 * wid;
            if (!(baseW - 31 >= -128 && baseW + 63 <= 128)) {
                const int base = baseW - r32;
#pragma unroll
                for (int r = 0; r < 16; ++r) { const int d0 = base + crow(r, hi), d1 = d0 + 32;
                    if (d0 < -128 || d0 > 128) p0[r] = -1e30f;
                    if (d1 < -128 || d1 > 128) p1[r] = -1e30f; }
            }
        }
    } else if constexpr (MODE == 2) {
        if (j >= 4) {
            const int kr = a.b_rs0 + (j - 4), qr = a.b_r0 + (wid >> 1);
            const int rs = min(max(qr - 4, 0), 56);
            if (!SKIP_B && (kr < rs || kr >= rs + 8)) {
#pragma unroll
                for (int r = 0; r < 16; ++r) { p0[r] = -1e30f; p1[r] = -1e30f; }
            } else {
                const int qc = (wid & 1) * 32 + r32, cs = min(max(qc - 8, 0), 48);
                const float* tb = btab + (kr - qr + 7) * 31;
#pragma unroll
                for (int r = 0; r < 16; ++r) { const int k0 = crow(r, hi), k1 = k0 + 32;
                    const float b0 = tb[min(max(k0 - qc + 15, 0), 30)], b1 = tb[min(max(k1 - qc + 15, 0), 30)];
                    p0[r] = (k0 >= cs && k0 < cs + 16) ? p0[r] + b0 : -1e30f;
                    p1[r] = (k1 >= cs && k1 < cs + 16) ? p1[r] + b1 : -1e30f;
                    if ((r & 3) == 3) asm volatile("" ::: "memory"); }
            }
        }
    }
}

template <int MODE>
__device__ __forceinline__ bool tile_dead(int j, const Args& a, int wid) {
    if constexpr (MODE == 1 && SKIP_A) { if (j < 4) return false; const int baseW = a.abase + 64 * (j - 4) - 32 * wid; return (baseW - 31 > 128) || (baseW + 63 < -128); }
    else if constexpr (MODE == 2 && SKIP_B) { if (j < 4) return false; const int kr = a.b_rs0 + (j - 4), qr = a.b_r0 + (wid >> 1), rs = min(max(qr - 4, 0), 56); return kr < rs || kr >= rs + 8; }
    else return false;
}
template <int MODE>
__device__ __forceinline__ void attn_body(const Args& a, char* lds) {
    const int tid = opaque_tid(), wid = __builtin_amdgcn_readfirstlane(tid >> 6), lane = tid & 63, r32 = lane & 31, hi = lane >> 5;
    char* V_lds = lds; char* K_lds = lds + 2 * SHM_V;
    float* ws = (float*)(lds + 2 * SHM_V + 2 * SHM_K) + wid * 64; float* li_l = ws; float* al_l = ws + 32;
    const float* btab = (const float*)(lds + BTAB_OFF);
    float m_reg = -1e30f, l_reg = 0; f32x16 o[4] = {}; bf16x8 qr[8];
    const bf16_t* Qw = a.Qb + (long)(wid * QBLK + r32) * LDQ + hi * 8;
#pragma unroll
    for (int d0 = 0; d0 < 8; ++d0) qr[d0] = *reinterpret_cast<const bf16x8*>(Qw + d0 * 16);
    if (a.qg != nullptr || a.q_rope) {
        float q[8][8];
#pragma unroll
        for (int d0 = 0; d0 < 8; ++d0) { const u32x4 w = *reinterpret_cast<const u32x4*>(&qr[d0]);
#pragma unroll
            for (int c = 0; c < 4; ++c) { q[d0][2 * c] = bf_lo(w[c]); q[d0][2 * c + 1] = bf_hi(w[c]); } }
        if (a.qg != nullptr) {
            float ss = 0.f;
#pragma unroll
            for (int d0 = 0; d0 < 8; ++d0)
#pragma unroll
                for (int i = 0; i < 8; ++i) ss += q[d0][i] * q[d0][i];
            { auto rr = __builtin_amdgcn_permlane32_swap(__float_as_uint(ss), __float_as_uint(ss), false, false); ss = __uint_as_float(rr[0]) + __uint_as_float(rr[1]); }
            const float rstd = rsqrtf(ss * (1.f / 128.f) + EPS);
#pragma unroll
            for (int d0 = 0; d0 < 8; ++d0) { const f32x4 g0 = *(const f32x4*)(a.qg + d0 * 16 + hi * 8), g1 = *(const f32x4*)(a.qg + d0 * 16 + hi * 8 + 4);
#pragma unroll
                for (int i = 0; i < 4; ++i) { q[d0][i] *= rstd * g0[i]; q[d0][4 + i] *= rstd * g1[i]; } }
        }
        if (a.q_rope) {
            const float2* rtab = (const float2*)(lds + RTAB_OFF);
            const int t = a.q_t0 + wid * QBLK + r32;
#pragma unroll
            for (int hb = 0; hb < 2; ++hb) { const int pos = hb ? (t & 63) : (t >> 6);
#pragma unroll
                for (int dd = 0; dd < 2; ++dd) { const int d0 = hb * 4 + dd;
#pragma unroll
                    for (int i = 0; i < 8; ++i) { const float2 cs = rtab[pos * 32 + dd * 16 + hi * 8 + i]; const float x1 = q[d0][i], x2 = q[d0 + 2][i];
                        q[d0][i] = x1 * cs.x - x2 * cs.y; q[d0 + 2][i] = x2 * cs.x + x1 * cs.y; } } }
        }
#pragma unroll
        for (int d0 = 0; d0 < 8; ++d0) { u32x4 w; w.x = cvt_pk_bf16(q[d0][0], q[d0][1]); w.y = cvt_pk_bf16(q[d0][2], q[d0][3]); w.z = cvt_pk_bf16(q[d0][4], q[d0][5]); w.w = cvt_pk_bf16(q[d0][6], q[d0][7]);
            qr[d0] = *reinterpret_cast<bf16x8*>(&w); }
    }
    const int sr = tid >> 4, sc = (tid & 15) * 8, vst0 = v_st(sr, sc), vst1 = v_st(32 + sr, sc);
    const int vb0 = (int)(uintptr_t)V_lds + v_rd_base(lane);
    struct { bf16x8 vs0, vs1, ks0, ks1; } sr_[SDEPTH];
    const unsigned goff = (unsigned)(sr * LDK + sc) * 2u, goff1 = goff + 32u * LDK * 2u;
#define KROW(j) ((j) < 4 ? a.ctx_row0 + 64 * (j) : a.lat_row0 + 64 * ((j) - 4))
#define SLOAD(i, j) do { const size_t _kb = (size_t)KROW(j) * (LDK * 2); const char* _vp = (const char*)a.Vb + _kb; const char* _kp = (const char*)a.Kb + _kb; \
    sr_[i].vs0 = *(const bf16x8*)(_vp + goff); sr_[i].vs1 = *(const bf16x8*)(_vp + goff1); \
    sr_[i].ks0 = *(const bf16x8*)(_kp + goff); sr_[i].ks1 = *(const bf16x8*)(_kp + goff1); } while (0)
#define SWRITE(b, i) do { *(bf16x8*)(V_lds + (b) * SHM_V + vst0) = sr_[i].vs0;          \
    *(bf16x8*)(V_lds + (b) * SHM_V + vst1) = sr_[i].vs1; int kc = sc * 2;               \
    *(bf16x8*)(K_lds + (b) * SHM_K + KSWZ(sr, kc)) = sr_[i].ks0;                       \
    *(bf16x8*)(K_lds + (b) * SHM_K + KSWZ(32 + sr, kc)) = sr_[i].ks1; } while (0)
#define SWAIT() do { if constexpr (SDEPTH == 2) asm volatile("s_waitcnt vmcnt(4)" ::: "memory"); else asm volatile("s_waitcnt vmcnt(0)" ::: "memory"); } while (0)
#define RESC(al) do { if (__any((al) < 1.f)) { if (hi == 0) al_l[r32] = (al); asm volatile("s_waitcnt lgkmcnt(0)" ::: "memory"); \
    _Pragma("unroll") for (int d = 0; d < 4; ++d) _Pragma("unroll") for (int r = 0; r < 16; ++r) o[d][r] *= al_l[crow(r, hi)]; } } while (0)
    f32x16 pA0, pA1, pB0, pB1; float mnA, mnB, alA, alB; bf16x8 pa0, pa1, pa2, pa3; const int NT = a.NT;
    constexpr int SE = 0, SO = SDEPTH - 1;
    SLOAD(SE, 0); asm volatile("s_waitcnt vmcnt(0)" ::: "memory"); SWRITE(0, SE); __syncthreads();
    qkt(pA0, pA1, K_lds, qr, r32, hi); partialSM(pA0, pA1, m_reg, mnA, alA);
    SLOAD(SO, 1); if constexpr (SDEPTH == 2) { if (2 < NT) SLOAD(SE, 2); }
    SWAIT(); SWRITE(1, SO); __syncthreads();
    bool dA = false, dB = false;
    for (int j = 1; j + 1 < NT; j += 2) {
        dB = tile_dead<MODE>(j, a, wid);
        SBAR(); if (!dB) qkt(pB0, pB1, K_lds + SHM_K, qr, r32, hi);
        if (!dA) finishSM(pA0, pA1, alA, l_reg, pa0, pa1, pa2, pa3); SBAR();
        SLOAD(SO, j + SDEPTH); SBAR();
        if (!dA) pv_d0(o, vb0, pa0, pa1, pa2, pa3);
        if (!dB) { apply_mask<MODE>(pB0, pB1, j, a, wid, r32, hi, btab); partialSM(pB0, pB1, m_reg, mnB, alB); } else alB = 1.f;
        __syncthreads(); SWAIT(); SWRITE(0, SE);
        RESC(alB); __syncthreads();
        dA = tile_dead<MODE>(j + 1, a, wid);
        SBAR(); if (!dA) qkt(pA0, pA1, K_lds, qr, r32, hi);
        if (!dB) finishSM(pB0, pB1, alB, l_reg, pa0, pa1, pa2, pa3); SBAR();
        if (SDEPTH == 1 || j + 3 < NT) SLOAD(SE, j + 1 + SDEPTH); SBAR();
        if (!dB) pv_d0(o, vb0 + (int)SHM_V, pa0, pa1, pa2, pa3);
        if (!dA) { apply_mask<MODE>(pA0, pA1, j + 1, a, wid, r32, hi, btab); partialSM(pA0, pA1, m_reg, mnA, alA); } else alA = 1.f;
        __syncthreads(); SWAIT(); SWRITE(1, SO);
        RESC(alA); __syncthreads();
    }
    dB = tile_dead<MODE>(NT - 1, a, wid);
    SBAR(); if (!dB) qkt(pB0, pB1, K_lds + SHM_K, qr, r32, hi);
    if (!dA) finishSM(pA0, pA1, alA, l_reg, pa0, pa1, pa2, pa3); SBAR();
    if (!dA) pv_d0(o, vb0, pa0, pa1, pa2, pa3);
    if (!dB) { apply_mask<MODE>(pB0, pB1, NT - 1, a, wid, r32, hi, btab); partialSM(pB0, pB1, m_reg, mnB, alB); } else alB = 1.f;
    __syncthreads(); RESC(alB);
    if (!dB) { finishSM(pB0, pB1, alB, l_reg, pa0, pa1, pa2, pa3); SBAR();
        pv_d0(o, vb0 + (int)SHM_V, pa0, pa1, pa2, pa3); }
    l_reg += __builtin_amdgcn_exp2f(a.sink_l2 - m_reg * (SCALE * 1.4426950408889634f));
    if (hi == 0) li_l[r32] = l_reg; asm volatile("s_waitcnt lgkmcnt(0)" ::: "memory");
    float rli[16];
#pragma unroll
    for (int r = 0; r < 16; ++r) rli[r] = __builtin_amdgcn_rcpf(li_l[crow(r, hi)]);
    const int odd = lane & 1;
    char* Ow = (char*)(a.Ob + (long)(wid * QBLK + 4 * hi + odd) * LDO + (r32 & ~1));
#pragma unroll
    for (int r = 0; r < 16; r += 2) {
#pragma unroll
        for (int d0 = 0; d0 < 4; ++d0) { const float va = o[d0][r] * rli[r], vb = o[d0][r + 1] * rli[r + 1];
            const float recv = xor_swz<1>(odd ? va : vb);
            const unsigned w = odd ? cvt_pk_bf16(recv, vb) : cvt_pk_bf16(va, recv);
            *(unsigned*)(Ow + ((r & 3) + 8 * (r >> 2)) * (LDO * 2) + d0 * 64) = w; } }
#undef KROW
#undef SLOAD
#undef SWRITE
#undef SWAIT
#undef RESC
}
}

__device__ __forceinline__ const float* xrow_c(const Params& p, int row, bool from_input) { return row < MLAT ? (from_input ? p.x : p.out) + (size_t)row * DM : (const float*)(p.ws + WS_XC) + (size_t)(row - MLAT) * DM; }
__device__ __forceinline__ int row_set(int row) { return row < MLAT ? (row >> 12) : 4; }

__device__ __forceinline__ void convert_tile(const float* __restrict__ W, bf16_t* __restrict__ WT, int K, int N, int kt, int nt, unsigned* l32, int nout0) {
    const int tid = opaque_tid(), n4 = tid & 15, kp = tid >> 4;
    const int k0 = kt * 256, n0 = nt * 64;
    __syncthreads();
#pragma unroll
    for (int it = 0; it < 4; ++it) {
        const int k = k0 + it * 64 + kp * 2;
        const f32x4 a = *(const f32x4*)(W + (size_t)k * N + n0 + n4 * 4), b = *(const f32x4*)(W + (size_t)(k + 1) * N + n0 + n4 * 4);
#pragma unroll
        for (int j = 0; j < 4; ++j) l32[(n4 * 4 + j) * 132 + it * 32 + kp] = cvt_pk_bf16(a[j], b[j]);
    }
    __syncthreads();
    const int n = tid >> 3, kc = tid & 7;
    const u32x4* src = (const u32x4*)(l32 + n * 132 + kc * 16);
    u32x4* dst = (u32x4*)(WT + (size_t)(nout0 + n) * K + k0 + kc * 32);
#pragma unroll
    for (int q = 0; q < 4; ++q) dst[q] = src[q];
}
__device__ void convert_weights(const Params& p, int l, unsigned char* lds, int mask) {
    bf16_t* WT = (bf16_t*)(p.ws + WS_WT);
    constexpr int T0 = 1280, T1 = T0 + 256, T2 = T1 + 256, T3 = T2 + 1408, T4 = T3 + 704;
    const int c0 = (mask & 1) ? 1280 : 0, c1 = (mask & 2) ? 256 : 0, c2 = (mask & 4) ? 256 : 0, c3 = (mask & 8) ? 1408 : 0, c4 = (mask & 16) ? 704 : 0;
    const int total = c0 + c1 + c2 + c3 + c4;
    const bool skew = (l == 0 && mask == 31 && gridDim.x == 256);
    const int id0 = skew ? (blockIdx.x < 192 ? (int)blockIdx.x : 2688 + (int)blockIdx.x - 192) : (int)blockIdx.x;
    const int idstep = skew ? (blockIdx.x < 192 ? 192 : 64) : (int)gridDim.x;
    const int idend = skew ? (blockIdx.x < 192 ? 2688 : T4) : total;
    for (int cid = id0; cid < idend; cid += idstep) {
        int r = cid, id;
        if (r < c0) id = r; else { r -= c0; if (r < c1) id = T0 + r; else { r -= c1; if (r < c2) id = T1 + r; else { r -= c2; if (r < c3) id = T2 + r; else id = T3 + (r - c3); } } }
        const float* W; bf16_t* O; int K, N, t;
        if (id < T0) { W = p.w_in + (size_t)l * DM * NQ; O = WT + WT_IN; K = DM; N = NQ; t = id; }
        else if (id < T1) { W = p.w_branch + (size_t)l * DM * DM; O = WT + WT_BR; K = DM; N = DM; t = id - T0; }
        else if (id < T2) { W = p.w_out + (size_t)l * DM * DM; O = WT + WT_OUT; K = DM; N = DM; t = id - T1; }
        else if (id < T3) { W = p.w_up + (size_t)l * DM * NUP; O = WT + WT_UP; K = DM; N = NUP; t = id - T2; }
        else { W = p.w_down + (size_t)l * DFF * DM; O = WT + WT_DOWN; K = DFF; N = DM; t = id - T3; }
        const int nnt = N / 64, n0 = (t % nnt) * 64;
        int nout0 = n0;
        if (id >= T2 && id < T3) { const int mm = n0 < DFF ? n0 : n0 - DFF; nout0 = (mm >> 7) * 256 + (n0 < DFF ? 0 : 128) + (mm & 127); }
        convert_tile(W, O, K, N, t / nnt, t % nnt, (unsigned*)lds, nout0);
    }
    __syncthreads();
}

__device__ void quant_rows(const bf16_t* __restrict__ Wt, unsigned char* __restrict__ W8, float* __restrict__ cs, int nrows) {
    const int tid = opaque_tid(), wid = tid >> 6, lane = tid & 63;
    for (int row = blockIdx.x * 8 + wid; row < nrows; row += gridDim.x * 8) {
        const u32x4* src = (const u32x4*)(Wt + (size_t)row * DM) + lane * 4;
        u32x4 w[4]; float f[32]; float mx = 0.f;
#pragma unroll
        for (int q = 0; q < 4; ++q) w[q] = src[q];
#pragma unroll
        for (int q = 0; q < 4; ++q)
#pragma unroll
            for (int c = 0; c < 4; ++c) { f[q * 8 + 2 * c] = bf_lo(w[q][c]); f[q * 8 + 2 * c + 1] = bf_hi(w[q][c]); }
#pragma unroll
        for (int i = 0; i < 32; ++i) mx = fmaxf(mx, fabsf(f[i]));
        mx = wave_max(mx);
        const float sc = mx > 0.f ? mx * (1.f / 127.f) : 1.f, inv = 1.f / sc;
        u32x4 o0, o1;
#pragma unroll
        for (int c = 0; c < 4; ++c) { o0[c] = pack_i8x4(f[4 * c] * inv, f[4 * c + 1] * inv, f[4 * c + 2] * inv, f[4 * c + 3] * inv);
                                      o1[c] = pack_i8x4(f[16 + 4 * c] * inv, f[17 + 4 * c] * inv, f[18 + 4 * c] * inv, f[19 + 4 * c] * inv); }
        u32x4* dst = (u32x4*)(W8 + (size_t)row * DM) + lane * 2;
        dst[0] = o0; dst[1] = o1;
        if (lane == 0) cs[row] = sc;
    }
}
__device__ void quant_weights(const Params& p, bool up) {
    const bf16_t* WT = (const bf16_t*)(p.ws + WS_WT);
    quant_rows(WT + WT_IN, p.ws + WS_W8IN, (float*)(p.ws + WS_CSIN), NQ);
    if (up) quant_rows(WT + WT_UP, p.ws + WS_W8UP, (float*)(p.ws + WS_CSUP), NUP);
}
__device__ void mod_phase(const Params& p, unsigned char* lds) {
    const int tid = opaque_tid();
    if ((int)blockIdx.x >= 192) return;
    float* sc = (float*)lds;
    float* red = (float*)(lds + 5 * DM * 4);
    __syncthreads();
    for (int i = tid; i < 5 * DM; i += NTHREADS) { const int s = i / DM, k = i % DM; const float v = s < 4 ? p.c[s * DM + k] : p.c_ctx[k]; sc[i] = v / (1.f + __expf(-v)); }
    __syncthreads();
    float* modv = (float*)(p.ws + WS_MOD);
    for (int it = blockIdx.x; it < 192; it += gridDim.x) {
        const int l = it / 96, cg0 = (it % 96) * 128;
        const int c4 = tid & 31, ks = tid >> 5;
        const float* W = p.w_ada + (size_t)l * DM * 6 * DM + cg0 + c4 * 4;
        f32x4 acc[5];
#pragma unroll
        for (int s = 0; s < 5; ++s) acc[s] = (f32x4){0.f, 0.f, 0.f, 0.f};
#pragma unroll 8
        for (int kk = 0; kk < 128; ++kk) { const int k = ks * 128 + kk; const f32x4 w = *(const f32x4*)(W + (size_t)k * 6 * DM);
#pragma unroll
            for (int s = 0; s < 5; ++s) acc[s] += sc[s * DM + k] * w; }
#pragma unroll
        for (int s = 0; s < 5; ++s) *(f32x4*)(red + (ks * 5 + s) * 128 + c4 * 4) = acc[s];
        __syncthreads();
        for (int i = tid; i < 5 * 128; i += NTHREADS) { const int s = i / 128, cc = i % 128; float v = p.b_ada[(size_t)l * 6 * DM + cg0 + cc];
#pragma unroll
            for (int k2 = 0; k2 < 16; ++k2) v += red[(k2 * 5 + s) * 128 + cc];
            modv[((size_t)l * 5 + s) * 6 * DM + cg0 + cc] = v; }
        __syncthreads();
    }
}

__device__ void phase_init(const Params& p, unsigned char* lds) {
    { const int tid = opaque_tid(); const f32x4* s4 = (const f32x4*)p.ctx; f32x4* d4 = (f32x4*)(p.ws + WS_XC); const long n4 = (long)MCTX * DM / 4;
      for (long i = (long)blockIdx.x * NTHREADS + tid; i < n4; i += (long)gridDim.x * NTHREADS) d4[i] = s4[i]; }
#ifdef PROBE_CONV2
    for (int rep = 0; rep < 2; ++rep) { mod_phase(p, lds); __syncthreads(); convert_weights(p, 0, lds, 31); }
#else
    mod_phase(p, lds);
    convert_weights(p, 0, lds, 31);
#endif
}

__device__ void phase_norm(const Params& p, int l, int which, int mrows, bf16_t* H, bool fold, bool q8) {
    const int tid = opaque_tid(), wid = tid >> 6, lane = tid & 63;
    const float* nw = (which ? p.norm2 : p.norm1) + (size_t)l * DM;
    const float* modl = (const float*)(p.ws + WS_MOD) + (size_t)l * 5 * 6 * DM;
    const bool from_in = (l == 0 && which == 0);
    const int stride = gridDim.x * 8;
    int row = blockIdx.x * 8 + wid;
    f32x4 v[8], vn[8];
    if (row < mrows) { const f32x4* xp = (const f32x4*)xrow_c(p, row, from_in);
#pragma unroll
        for (int i = 0; i < 8; ++i) v[i] = xp[i * 64 + lane]; }
    while (row < mrows) {
        const int nrow = row + stride;
        if (nrow < mrows) { const f32x4* xq = (const f32x4*)xrow_c(p, nrow, from_in);
#pragma unroll
            for (int i = 0; i < 8; ++i) vn[i] = xq[i * 64 + lane]; }
        const float* shift = modl + (size_t)row_set(row) * 6 * DM + (which ? 3 : 0) * DM; const float* scale = shift + DM;
        float ss = 0.f;
        if (fold && row >= MLAT) {
            const f32x4* pp = (const f32x4*)(p.ws + WS_PART) + (size_t)(row - MLAT) * (DM / 4);
#pragma unroll
            for (int s2 = 0; s2 < 8; ++s2)
#pragma unroll
                for (int i = 0; i < 8; ++i) v[i] += pp[(size_t)s2 * MCTX * (DM / 4) + i * 64 + lane];
            f32x4* xw = (f32x4*)(p.ws + WS_XC) + (size_t)(row - MLAT) * (DM / 4);
#pragma unroll
            for (int i = 0; i < 8; ++i) xw[i * 64 + lane] = v[i];
        }
#pragma unroll
        for (int i = 0; i < 8; ++i) ss += v[i][0] * v[i][0] + v[i][1] * v[i][1] + v[i][2] * v[i][2] + v[i][3] * v[i][3];
        ss = wave_sum(ss);
        const float rstd = rsqrtf(ss * (1.f / DM) + EPS);
        if (q8) {
            float mx = 0.f;
#pragma unroll
            for (int i = 0; i < 8; ++i) { const int col = (i * 64 + lane) * 4;
                const f32x4 g = *(const f32x4*)(nw + col), sh = *(const f32x4*)(shift + col), scv = *(const f32x4*)(scale + col);
                f32x4 y = v[i] * rstd * g; y = y * (1.f + scv) + sh; v[i] = y;
                mx = fmaxf(mx, fmaxf(fmaxf(fabsf(y[0]), fabsf(y[1])), fmaxf(fabsf(y[2]), fabsf(y[3])))); }
            mx = wave_max(mx);
            const float sc = mx > 0.f ? mx * (1.f / 127.f) : 1.f, inv = 1.f / sc;
            unsigned* hq = (unsigned*)((unsigned char*)H + (size_t)row * DM);
#pragma unroll
            for (int i = 0; i < 8; ++i) hq[i * 64 + lane] = pack_i8x4(v[i][0] * inv, v[i][1] * inv, v[i][2] * inv, v[i][3] * inv);
            if (lane == 0) ((float*)(p.ws + WS_RS))[row] = sc;
        } else {
#pragma unroll
        for (int i = 0; i < 8; ++i) { const int col = (i * 64 + lane) * 4;
            const f32x4 g = *(const f32x4*)(nw + col), sh = *(const f32x4*)(shift + col), scv = *(const f32x4*)(scale + col);
            f32x4 y = v[i] * rstd * g; y = y * (1.f + scv) + sh;
            u32x2 w; w.x = cvt_pk_bf16(y[0], y[1]); w.y = cvt_pk_bf16(y[2], y[3]);
            *(u32x2*)(H + (size_t)row * DM + col) = w; }
        }
#pragma unroll
        for (int i = 0; i < 8; ++i) v[i] = vn[i];
        row = nrow;
    }
}
__device__ void phase_final(const Params& p) {
    const int tid = opaque_tid(), wid = tid >> 6, lane = tid & 63;
    const int stride = gridDim.x * 8;
    int row = blockIdx.x * 8 + wid;
    f32x4 v[8], vn[8];
    if (row < MLAT) { const f32x4* xp = (const f32x4*)(p.out + (size_t)row * DM);
#pragma unroll
        for (int i = 0; i < 8; ++i) v[i] = xp[i * 64 + lane]; }
    while (row < MLAT) {
        const int nrow = row + stride;
        if (nrow < MLAT) { const f32x4* xq = (const f32x4*)(p.out + (size_t)nrow * DM);
#pragma unroll
            for (int i = 0; i < 8; ++i) vn[i] = xq[i * 64 + lane]; }
        f32x4* xp = (f32x4*)(p.out + (size_t)row * DM);
        float ss = 0.f;
#pragma unroll
        for (int i = 0; i < 8; ++i) ss += v[i][0] * v[i][0] + v[i][1] * v[i][1] + v[i][2] * v[i][2] + v[i][3] * v[i][3];
        ss = wave_sum(ss);
        const float rstd = rsqrtf(ss * (1.f / DM) + EPS);
#pragma unroll
        for (int i = 0; i < 8; ++i) { const int col = (i * 64 + lane) * 4; const f32x4 g = *(const f32x4*)(p.final_norm + col); xp[i * 64 + lane] = v[i] * rstd * g; }
#pragma unroll
        for (int i = 0; i < 8; ++i) v[i] = vn[i];
        row = nrow;
    }
}

__device__ void phase_rope(const Params& p, int l, unsigned char* lds) {
    const int tid = opaque_tid();
    float2* tab = (float2*)lds;
    __syncthreads();
    for (int i = tid; i < 2048; i += NTHREADS) { const int pos = i >> 5, j = i & 31; const float inv = exp2f(-(float)j * (13.287712379549449f / 32.f)); float s, c; sincosf((float)pos * inv, &s, &c); tab[i] = make_float2(c, s); }
    __syncthreads();
    bf16_t* QKVG = (bf16_t*)(p.ws + WS_R1);
    const int sub = tid & 15, grp = tid >> 4;
    const float* qn = p.qnorm_c + l * 128; const float* kn = p.knorm_c + l * 128;
    const long nlat = (long)MLAT * 4, total = nlat + (long)MCTX * 2;
    const long stride = (long)gridDim.x * 32;
    for (long id0 = (long)blockIdx.x * 32 + grp; id0 < total; id0 += 4 * stride) {
        bf16_t* ptr[4]; u32x4 w[4]; int rowv[4], slotv[4];
#pragma unroll
        for (int u = 0; u < 4; ++u) {
            const long id = id0 + u * stride; const bool ok = id < total; const long idc = ok ? id : id0;
            int row, slot; if (idc < nlat) { row = (int)(idc >> 2); const int s4 = (int)(idc & 3); slot = s4 < 2 ? 6 + s4 : 12 + s4; } else { const long j = idc - nlat; row = MLAT + (int)(j >> 1); slot = 14 + (int)(j & 1); }
            const int col = slot < 6 ? QA + slot * 128 : (slot < 8 ? KA + (slot - 6) * 128 : (slot < 14 ? QC + (slot - 8) * 128 : KC + (slot - 14) * 128));
            ptr[u] = QKVG + (size_t)row * QP + col + sub * 8; rowv[u] = row; slotv[u] = ok ? slot : -1;
            w[u] = *(const u32x4*)ptr[u];
        }
#pragma unroll
        for (int u = 0; u < 4; ++u) {
            const int row = rowv[u], slot = slotv[u];
            const bool lat = row < MLAT, isC = slot >= 8;
            float v[8];
#pragma unroll
            for (int q = 0; q < 4; ++q) { v[2 * q] = bf_lo(w[u][q]); v[2 * q + 1] = bf_hi(w[u][q]); }
            if (isC) {
                const float* gw = slot < 14 ? qn : kn;
                float ss = 0.f;
#pragma unroll
                for (int i = 0; i < 8; ++i) ss += v[i] * v[i];
                ss += xor_swz<1>(ss); ss += xor_swz<2>(ss); ss += xor_swz<4>(ss); ss += xor_swz<8>(ss);
                const float rstd = rsqrtf(ss * (1.f / 128.f) + EPS);
                const f32x4 g0 = *(const f32x4*)(gw + sub * 8), g1 = *(const f32x4*)(gw + sub * 8 + 4);
#pragma unroll
                for (int i = 0; i < 4; ++i) { v[i] = v[i] * rstd * g0[i]; v[4 + i] = v[4 + i] * rstd * g1[i]; }
            }
            float pv[8];
#pragma unroll
            for (int i = 0; i < 8; ++i) pv[i] = xor_swz<4>(v[i]);
            if (lat) {
                const int t = row & (SEQ - 1); const int pos = (sub & 8) ? (t & 63) : (t >> 6);
                const bool upper = (sub & 4) != 0; const int j0 = (sub & 3) * 8;
#pragma unroll
                for (int i = 0; i < 8; ++i) { const float2 cs = tab[pos * 32 + j0 + i]; v[i] = upper ? v[i] * cs.x + pv[i] * cs.y : v[i] * cs.x - pv[i] * cs.y; }
            }
            if (slot >= 0) { u32x4 o; o.x = cvt_pk_bf16(v[0], v[1]); o.y = cvt_pk_bf16(v[2], v[3]); o.z = cvt_pk_bf16(v[4], v[5]); o.w = cvt_pk_bf16(v[6], v[7]);
                *(u32x4*)ptr[u] = o; }
        }
    }
}

__device__ void phase_glufix(const Params& p, int l, int mrows) {
    bf16_t* Gb = (bf16_t*)(p.ws + WS_R1);
    const float* ES = (const float*)(p.ws + WS_EDGE); const float* EA = ES + (size_t)EDGE_N; const float* EU = EA + (size_t)EDGE_N;
    const float* cw = p.conv_w + (size_t)l * 3 * DFF;
    constexpr int NC4 = DFF / 4;
    const int tid = opaque_tid();
    const long total = (long)(mrows / 64) * 2 * NC4;
    for (long id = (long)blockIdx.x * NTHREADS + tid; id < total; id += (long)gridDim.x * NTHREADS) {
        const int c4 = (int)(id % NC4), be = (int)(id / NC4), blk = be >> 1, e = be & 1;
        const int sb = blk < MLAT / 64 ? (blk & 63) : ((blk - MLAT / 64) & 3), sl = blk < MLAT / 64 ? 63 : 3;
        if (e == 0 ? sb == 0 : sb == sl) continue;
        const int nb = e ? (blk + 1) * 2 : (blk - 1) * 2 + 1;
        const f32x4 s = *(const f32x4*)(ES + (size_t)be * DFF + 4 * c4), an = *(const f32x4*)(EA + (size_t)nb * DFF + 4 * c4), uu = *(const f32x4*)(EU + (size_t)be * DFF + 4 * c4);
        const f32x4 w = *(const f32x4*)(cw + (e ? 2 * DFF : 0) + 4 * c4);
        float g[4];
#pragma unroll
        for (int i = 0; i < 4; ++i) { const float v = s[i] + w[i] * an[i]; g[i] = v * __builtin_amdgcn_rcpf(1.f + __expf(-v)) * uu[i]; }
        u32x2 o; o.x = cvt_pk_bf16(g[0], g[1]); o.y = cvt_pk_bf16(g[2], g[3]);
        *(u32x2*)(Gb + (size_t)(blk * 64 + 63 * e) * DFF + 4 * c4) = o;
    }
}

__device__ void phase_attn(const Params& p, int l, unsigned char* lds, int ctr_off) {
    unsigned* ctr = (unsigned*)(p.ws + WS_CTL) + l + ctr_off;
    const int nitems = (l == DEPTH - 1) ? 1024 : 1088;
    volatile int* sh = (volatile int*)(lds + LDS_MISC);
    const bf16_t* QKVG = (const bf16_t*)(p.ws + WS_R1);
    bf16_t* O = (bf16_t*)(p.ws + WS_B + BUF1);
    float* btab = (float*)(lds + att::BTAB_OFF);
    constexpr float L2E = 1.4426950408889634f;
    { const int t0 = opaque_tid(); float2* rtab = (float2*)(lds + att::RTAB_OFF);
      __syncthreads();
      for (int i = t0; i < 2048; i += NTHREADS) { const int pos = i >> 5, j = i & 31; const float inv = exp2f(-(float)j * (13.287712379549449f / 32.f)); float s, c; sincosf((float)pos * inv, &s, &c); rtab[i] = make_float2(c, s); }
      __syncthreads(); }
    for (;;) {
        const int tid = opaque_tid();
        __syncthreads();
        if (tid == 0) sh[0] = (int)atomicAdd(ctr, 1u);
        __syncthreads();
        const int it = __builtin_amdgcn_readfirstlane(sh[0]);
        if (it >= nitems) break;
        att::Args a; a.sink_l2 = -1e30f; a.abase = 0; a.b_r0 = 0; a.b_rs0 = 0; a.qg = nullptr; a.q_rope = 0; a.q_t0 = 0;
        if (it < 768) {
            const bool isC = it < 384; const int i = isC ? it : it - 384;
            const int b = i / 96, r = i % 96, kvh = r / 48, r2 = r % 48, g = r2 >> 4, qt = r2 & 15, h = kvh * 3 + g;
            const int row0 = b * SEQ + qt * 256;
            a.ctx_row0 = MLAT + b * CTXL;
            if (isC) {
                a.Qb = QKVG + (size_t)row0 * QP + QC + h * 128; a.Kb = QKVG + KC + kvh * 128; a.Vb = QKVG + VC + kvh * 128; a.Ob = O + (size_t)row0 * DM + OC + h * 128;
                a.lat_row0 = b * SEQ; a.NT = 68; a.qg = p.qnorm_c + l * 128; a.q_rope = 1; a.q_t0 = qt * 256;
                att::attn_body<0>(a, (char*)lds);
            } else {
                const int q0 = qt * 256, ks = max(q0 - 128, 0), ke = min(q0 + 384, SEQ);
                a.Qb = QKVG + (size_t)row0 * QP + QA + h * 128; a.Kb = QKVG + KA + kvh * 128; a.Vb = QKVG + VA + kvh * 128; a.Ob = O + (size_t)row0 * DM + OA + h * 128;
                a.lat_row0 = b * SEQ + ks; a.NT = 4 + (ke - ks) / 64; a.abase = ks - q0; a.sink_l2 = p.sink_a[l * 6 + h] * L2E; a.q_rope = 1; a.q_t0 = q0;
                att::attn_body<1>(a, (char*)lds);
            }
        } else if (it < 1024) {
            const int i = it - 768, b = i >> 6, h = (i & 63) >> 4, qt = i & 15, r0 = qt * 4;
            const int rs0 = min(max(r0 - 4, 0), 56), rend = min(max(r0 - 1, 0), 56) + 8;
            const int row0 = b * SEQ + qt * 256;
            for (int k = tid; k < 15 * 31; k += NTHREADS) btab[k] = p.rpb_b[((size_t)l * 4 + h) * 465 + k] * 11.313708498984761f;
            a.ctx_row0 = MLAT + b * CTXL;
            a.Qb = QKVG + (size_t)row0 * QP + QB + h * 128; a.Kb = QKVG + KB + h * 128; a.Vb = QKVG + VB + h * 128; a.Ob = O + (size_t)row0 * DM + OB + h * 128;
            a.lat_row0 = b * SEQ + rs0 * 64; a.NT = (4 + (rend - rs0) + 1) & ~1; a.b_r0 = r0; a.b_rs0 = rs0;
            att::attn_body<2>(a, (char*)lds);
        } else {
            const int i = it - 1024, b = i >> 4, hs = i & 15;
            const int row0 = MLAT + b * CTXL;
            int qc, kc, vc, oc;
            if (hs < 6) { const int h = hs, kvh = h / 3; qc = QA + h * 128; kc = KA + kvh * 128; vc = VA + kvh * 128; oc = OA + h * 128; a.sink_l2 = p.sink_a[l * 6 + h] * L2E; }
            else if (hs < 10) { const int h = hs - 6; qc = QB + h * 128; kc = KB + h * 128; vc = VB + h * 128; oc = OB + h * 128; }
            else { const int h = hs - 10, kvh = h / 3; qc = QC + h * 128; kc = KC + kvh * 128; vc = VC + kvh * 128; oc = OC + h * 128; a.qg = p.qnorm_c + l * 128; }
            a.ctx_row0 = row0; a.lat_row0 = 0; a.NT = 4;
            a.Qb = QKVG + (size_t)row0 * QP + qc; a.Kb = QKVG + kc; a.Vb = QKVG + vc; a.Ob = O + (size_t)row0 * DM + oc;
            att::attn_body<0>(a, (char*)lds);
        }
    }
}

#define XB_TMO      128
#define XB_XCNT(j)  (256  + 64 * (j))
#define XB_XSUB(j)  (1280 + 64 * (j))
#define XB_XGEN(j)  (2304 + 64 * (j))
#define XB_TOP      3328
#define XB_TOPGEN   3392
#define XCD_BAR_WORDS 3456
#define XB_SPIN_CAP (1u << 20)
__device__ __forceinline__ unsigned xb_ld(unsigned* p)              { return __hip_atomic_load(p, __ATOMIC_RELAXED, __HIP_MEMORY_SCOPE_AGENT); }
__device__ __forceinline__ unsigned xb_add(unsigned* p, unsigned v) { return __hip_atomic_fetch_add(p, v, __ATOMIC_RELAXED, __HIP_MEMORY_SCOPE_AGENT); }
__device__ __forceinline__ unsigned xb_xcc_id() { return (unsigned)__builtin_amdgcn_s_getreg((3 << 11) | 20) & 0xFu; }
#define XB_SPIN(cond, bar) do { unsigned _sp = 0; while (cond) { __builtin_amdgcn_s_sleep(1); \
    if ((++_sp & 255u) == 0u) { if (xb_ld(&(bar)[XB_TMO])) break; if (_sp > XB_SPIN_CAP) { atomicAdd(&(bar)[XB_TMO], 1u); break; } } } } while (0)
struct XcdBarrier { unsigned* bar; unsigned x; volatile LAS unsigned* st; };
__device__ __forceinline__ XcdBarrier xcd_barrier_post(unsigned* bar, volatile LAS unsigned* st) {
    XcdBarrier b; b.bar = bar; b.x = xb_xcc_id(); b.st = st;
    if (threadIdx.x == 0) (void)xb_add(&bar[XB_XCNT(b.x)], 1u);
    return b;
}
__device__ __forceinline__ void xcd_barrier_complete(unsigned* bar, unsigned x, unsigned& nloc, unsigned& nx) {
    const unsigned G = gridDim.x * gridDim.y * gridDim.z;
    unsigned sum, cnt, mine, sp = 0u;
    for (;;) {
        sum = 0u; cnt = 0u; mine = 0u;
#pragma unroll
        for (unsigned j = 0; j < 16; ++j) { const unsigned c = xb_ld(&bar[XB_XCNT(j)]); sum += c; cnt += (c > 0u) ? 1u : 0u; mine = (j == x) ? c : mine; }
        if (sum == G) break;
        __builtin_amdgcn_s_sleep(1);
        if ((++sp & 255u) == 0u) { if (xb_ld(&bar[XB_TMO])) break; if (sp > XB_SPIN_CAP) { atomicAdd(&bar[XB_TMO], 1u); break; } }
    }
    nloc = mine > 0u ? mine : 1u; nx = cnt > 0u ? cnt : 1u;
}
__device__ __forceinline__ void xcd_barrier(const XcdBarrier& b) {
    asm volatile("s_waitcnt vmcnt(0)" ::: "memory");
    __syncthreads();
    if (threadIdx.x == 0) {
        unsigned* bar = b.bar;
        __builtin_amdgcn_s_waitcnt(0);
        unsigned nloc = b.st[0], nx = b.st[1];
        if (nloc == 0u) { xcd_barrier_complete(bar, b.x, nloc, nx); b.st[0] = nloc; b.st[1] = nx; }
        const unsigned old = xb_add(&bar[XB_XSUB(b.x)], 1u);
        const unsigned gen = old / nloc;
        if (old + 1u == (gen + 1u) * nloc) {
            __builtin_amdgcn_fence(__ATOMIC_RELEASE, "agent");
            asm volatile("s_waitcnt vmcnt(0)" ::: "memory");
            const unsigned og = xb_add(&bar[XB_TOP], 1u);
            const unsigned tg = og / nx;
            if (og + 1u == (tg + 1u) * nx) xb_add(&bar[XB_TOPGEN], 1u);
            else XB_SPIN(xb_ld(&bar[XB_TOPGEN]) == tg, bar);
            __builtin_amdgcn_fence(__ATOMIC_ACQUIRE, "agent");
            xb_add(&bar[XB_XGEN(b.x)], 1u);
            asm volatile("s_waitcnt vmcnt(0)" ::: "memory");
        } else {
            XB_SPIN(xb_ld(&bar[XB_XGEN(b.x)]) == gen, bar);
            __builtin_amdgcn_fence(__ATOMIC_ACQUIRE, "agent");
            asm volatile("s_waitcnt vmcnt(0)" ::: "memory");
        }
    }
    __syncthreads();
}

constexpr int NPHASES = 2 + 10 * DEPTH;

__device__ __forceinline__ void run_phase(const Params& p, int ph, unsigned char* shm) {
    LAS unsigned char* lds3 = (LAS unsigned char*)shm;
    bf16_t* WT = (bf16_t*)(p.ws + WS_WT);
    bf16_t* R1 = (bf16_t*)(p.ws + WS_R1);
    bf16_t* B1 = (bf16_t*)(p.ws + WS_B); bf16_t* B2 = (bf16_t*)(p.ws + WS_B + BUF1); bf16_t* B3 = (bf16_t*)(p.ws + WS_B + 2 * BUF1);
    float* xc = (float*)(p.ws + WS_XC);
    if (ph == 0) { phase_init(p, shm); return; }
    if (ph == NPHASES - 1) { phase_final(p); return; }
    const int l = (ph - 1) / 10, s = (ph - 1) % 10;
    const bool lastl = (l == DEPTH - 1);
    const int mrows = lastl ? MLAT : MTOT;
    const float* modl = (const float*)(p.ws + WS_MOD) + (size_t)l * 5 * 6 * DM;
    pg8::StaticOrder S;
    const bool upq = ((UP_I8_MASK >> l) & 1) != 0, upq_next = !lastl && ((UP_I8_MASK >> (l + 1)) & 1) != 0;
    switch (s) {
    case 0:
        if (l > 0) convert_weights(p, l, shm, upq ? (2 | 4 | 16) : (2 | 4 | 8 | 16));
        else quant_weights(p, upq);
        phase_norm(p, l, 0, MTOT, B1, USE_SLABS && l > 0, true);
        break;
    case 7: {
        float* ES = (float*)(p.ws + WS_EDGE);
        if (upq) {
            pg8::Gemm g{B1, p.ws + WS_W8UP, mrows, NUP, DM};
            pg8::EpiGLU<true> E{R1, p.conv_w + (size_t)l * 3 * DFF, p.conv_b + (size_t)l * DFF, ES, ES + EDGE_N, ES + 2 * EDGE_N, 0, (const float*)(p.ws + WS_RS), (const float*)(p.ws + WS_CSUP)};
            S.init(g.M, g.N, g.PB, gridDim.x, blockIdx.x, 0);
            pg8::gemm_phase<pg8::EpiGLU<true>, true>(lds3, g, S, E);
        } else {
            pg8::Gemm g{B1, WT + WT_UP, mrows, NUP, DM * 2};
            pg8::EpiGLU<false> E{R1, p.conv_w + (size_t)l * 3 * DFF, p.conv_b + (size_t)l * DFF, ES, ES + EDGE_N, ES + 2 * EDGE_N, 0, nullptr, nullptr};
            S.init(g.M, g.N, g.PB, gridDim.x, blockIdx.x, 0);
            pg8::gemm_phase<pg8::EpiGLU<false>, false>(lds3, g, S, E);
        }
    } break;
    case 1: {
        pg8::Gemm g{B1, p.ws + WS_W8IN, MTOT, NQ, DM};
        pg8::EpiStoreQ E{R1, QP, (const float*)(p.ws + WS_RS), (const float*)(p.ws + WS_CSIN), p.ws + WS_GATES};
        S.init(g.M, g.N, g.PB, gridDim.x, blockIdx.x, 0);
        pg8::gemm_phase<pg8::EpiStoreQ, true>(lds3, g, S, E);
    } break;
    case 2:
        if (!lastl) convert_weights(p, l + 1, shm, upq_next ? (1 | 8) : 1);
        phase_rope(p, l, shm); break;
    case 3:
#ifdef PROBE_ATT2
        for (int rep = 2; rep >= 0; rep -= 2) { phase_attn(p, l, shm, rep); __syncthreads(); }
#else
        phase_attn(p, l, shm, 0);
#endif
        break;
    case 4: {
        pg8::Gemm g{B2, WT + WT_BR, mrows, DM, DM * 2}; pg8::EpiBranch E{p.ws + WS_GATES, B3, 0};
        S.init(g.M, g.N, g.PB, gridDim.x, blockIdx.x, 0);
#ifdef PROBE_GEMM2
        E.dry = 1; pg8::gemm_phase<pg8::EpiBranch>(lds3, g, S, E); E.dry = 0; __syncthreads();
#endif
        pg8::gemm_phase<pg8::EpiBranch>(lds3, g, S, E);
    } break;
    case 5: case 9: {
        pg8::Gemm g; pg8::EpiResid E;
        if (s == 5) { g = pg8::Gemm{B3, WT + WT_OUT, mrows, DM, DM * 2}; E = pg8::EpiResid{p.out, xc, l == 0 ? p.x : p.out, xc, modl + 2 * DM, (float*)(p.ws + WS_PART), 0}; }
        else { g = pg8::Gemm{R1, WT + WT_DOWN, mrows, DM, DFF * 2}; E = pg8::EpiResid{p.out, xc, p.out, xc, modl + 5 * DM, (float*)(p.ws + WS_PART), 0}; }
        S.init(g.M, g.N, g.PB, gridDim.x, blockIdx.x, USE_SLABS && !lastl ? MCTX / 256 : 0);
#ifdef PROBE_GEMM2
        E.dry = 1; pg8::gemm_phase<pg8::EpiResid>(lds3, g, S, E); E.dry = 0; __syncthreads();
#endif
        pg8::gemm_phase<pg8::EpiResid>(lds3, g, S, E);
    } break;
    case 6: phase_norm(p, l, 1, mrows, B1, USE_SLABS && !lastl, upq); break;
    case 8:
        if (!lastl) quant_weights(p, upq_next);
        phase_glufix(p, l, mrows); break;
    }
}

__global__ void __launch_bounds__(NTHREADS, 2) mega(Params p) {
    extern __shared__ __attribute__((aligned(16))) unsigned char shm[];
    cg::grid_group grid = cg::this_grid();
    volatile LAS unsigned* st = (volatile LAS unsigned*)((LAS unsigned char*)shm + LDS_MISC + 64);
    if (threadIdx.x == 0) { st[0] = 0u; st[1] = 0u; }
    __syncthreads();
    XcdBarrier xb{};
    if (p.coop) xb = xcd_barrier_post((unsigned*)(p.ws + WS_BAR), st);
#ifdef PROBE_REPEAT_S
    bool again = false;
#endif
    for (int ph = p.ph_lo; ph < p.ph_hi; ++ph) {
        run_phase(p, ph, shm);
        if (p.coop && ph + 1 < p.ph_hi) {
            if (p.pad == 0x5eed) grid.sync();
            else xcd_barrier(xb);
        }
#ifdef PROBE_REPEAT_S
        if (ph >= 1 && ph < NPHASES - 1 && ((ph - 1) % 10) == PROBE_REPEAT_S && !again) { again = true; --ph; } else again = false;
#endif
    }
}

extern "C" void kernel_launch(void* const* d_in, const int* in_sizes, int n_in, void* d_out, int out_size, void* d_ws, size_t ws_size, hipStream_t stream) {
    static int grid = 0;
    if (grid == 0) {
        if (n_in != 20 || ws_size < WS_END) { fprintf(stderr, "kernel_launch: unexpected n_in %d / ws %zu (need %zu)\n", n_in, ws_size, (size_t)WS_END); grid = -1; return; }
        if (hipFuncSetAttribute((const void*)mega, hipFuncAttributeMaxDynamicSharedMemorySize, LDS_BYTES) != hipSuccess) { fprintf(stderr, "kernel_launch: hipFuncSetAttribute failed\n"); grid = -1; return; }
        int dev = 0, cus = 0, per_cu = 0;
        hipGetDevice(&dev); hipDeviceGetAttribute(&cus, hipDeviceAttributeMultiprocessorCount, dev);
        if (hipOccupancyMaxActiveBlocksPerMultiprocessor(&per_cu, (const void*)mega, NTHREADS, LDS_BYTES) != hipSuccess || per_cu < 1) { fprintf(stderr, "kernel_launch: occupancy query gave %d\n", per_cu); per_cu = 1; }
        (void)hipGetLastError();
        grid = cus;
    }
    if (grid < 0) return;
    if (hipMemsetAsync((char*)d_ws + WS_CTL, 0, WS_CTL_BYTES, stream) != hipSuccess) { fprintf(stderr, "kernel_launch: memset of the control words failed\n"); return; }
    Params p{};
    const float** f = (const float**)&p;
    for (int i = 0; i < 20; ++i) f[i] = (const float*)d_in[i];
    p.out = (float*)d_out; p.ws = (unsigned char*)d_ws;
#if MK_COOP
    p.ph_lo = 0; p.ph_hi = NPHASES; p.coop = 1; p.pad = 0;
    void* args[] = {&p};
    hipError_t e = hipLaunchCooperativeKernel((const void*)mega, dim3(grid), dim3(NTHREADS), args, LDS_BYTES, stream);
    if (e != hipSuccess) fprintf(stderr, "kernel_launch: cooperative launch failed: %s (grid %d)\n", hipGetErrorString(e), grid);
#else
    for (int ph = 0; ph < NPHASES; ++ph) {
        p.ph_lo = ph; p.ph_hi = ph + 1; p.coop = 0; p.pad = 0;
        hipLaunchKernelGGL(mega, dim3(grid), dim3(NTHREADS), LDS_BYTES, stream, p);
    }
#endif
}
```

```cpp
#include <hip/hip_runtime.h>
#include <hip/hip_cooperative_groups.h>
#include <cstdio>
#include <cstdint>
namespace cg = cooperative_groups;

#ifndef MK_COOP
#define MK_COOP 1
#endif

#define LAS __attribute__((address_space(3)))
typedef unsigned short bf16_t;
typedef short bf16x8 __attribute__((ext_vector_type(8)));
typedef short s16x4 __attribute__((ext_vector_type(4)));
typedef float f32x4 __attribute__((ext_vector_type(4)));
typedef float f32x16 __attribute__((ext_vector_type(16)));
typedef unsigned u32x4 __attribute__((ext_vector_type(4)));
typedef unsigned u32x2 __attribute__((ext_vector_type(2)));
typedef int i32x4 __attribute__((ext_vector_type(4)));
#ifndef UP_I8_MASK
#define UP_I8_MASK 1
#endif

constexpr int DM = 2048, NBATCH = 4, SEQ = 4096, CTXL = 256, DEPTH = 2;
constexpr int MLAT = NBATCH * SEQ, MCTX = NBATCH * CTXL, MTOT = MLAT + MCTX;
constexpr int NQ = 10240, DFF = 5632, NUP = 2 * DFF;
constexpr int QT = 16;
constexpr int QP = 4096 + 64;
constexpr int QA = 0, KA = 768, VA = 1024, QB = 1280, KB = 1792, VB = 2304, QC = 2816, KC = 3584, VC = 3840, GA = 4096, GB = 6144, GC = 8192;
constexpr int OA = 0, OB = 768, OC = 1280;
constexpr float EPS = 1e-6f;
constexpr int NTHREADS = 512;
constexpr int LDS_MISC = 131072, LDS_BYTES = 131072 + 2048;

constexpr size_t al256(size_t x) { return (x + 255) / 256 * 256; }
constexpr size_t WS_CTL = 0;
constexpr size_t WS_BAR = 4096;
constexpr size_t WS_CTL_BYTES = 4096 + 16384;
constexpr size_t WS_MOD = WS_CTL_BYTES;
constexpr size_t WS_XC = al256(WS_MOD + (size_t)DEPTH * 5 * 6 * DM * 4);
constexpr size_t WS_WT = al256(WS_XC + (size_t)MCTX * DM * 4);
constexpr size_t WT_IN = 0, WT_BR = WT_IN + (size_t)NQ * DM, WT_OUT = WT_BR + (size_t)DM * DM, WT_UP = WT_OUT + (size_t)DM * DM, WT_DOWN = WT_UP + (size_t)NUP * DM, WT_END = WT_DOWN + (size_t)DM * DFF;
constexpr size_t WS_R1 = al256(WS_WT + WT_END * 2);
constexpr size_t WS_GATES = al256(WS_R1 + (size_t)MTOT * QP * 2);
constexpr size_t WS_B = al256(WS_GATES + (size_t)3 * (MTOT / 256) * 8 * 131072);
constexpr size_t BUF1 = (size_t)MTOT * DM * 2;
constexpr size_t EDGE_N = (size_t)(MTOT / 64) * 2 * DFF;
constexpr size_t WS_EDGE = WS_B + BUF1;
static_assert(3 * EDGE_N * 4 <= 2 * BUF1, "edge buffers must fit B2+B3");
constexpr size_t WS_PART = al256(WS_B + 3 * BUF1);
constexpr size_t WS_W8IN = al256(WS_PART + (size_t)8 * MCTX * DM * 4);
constexpr size_t WS_W8UP = al256(WS_W8IN + (size_t)NQ * DM);
constexpr size_t WS_CSIN = al256(WS_W8UP + (size_t)NUP * DM);
constexpr size_t WS_CSUP = al256(WS_CSIN + (size_t)NQ * 4);
constexpr size_t WS_RS = al256(WS_CSUP + (size_t)NUP * 4);
constexpr size_t WS_END = WS_RS + (size_t)MTOT * 4;

struct Params {
    const float *x, *c, *ctx, *c_ctx, *w_ada, *b_ada, *norm1, *w_in, *sink_a, *rpb_b, *qnorm_c, *knorm_c, *w_branch, *w_out, *norm2, *w_up, *conv_w, *conv_b, *w_down, *final_norm;
    float* out; unsigned char* ws;
    int ph_lo, ph_hi, coop, pad;
};

__device__ __forceinline__ unsigned cvt_pk_bf16(float lo, float hi) { unsigned r; asm volatile("v_cvt_pk_bf16_f32 %0, %1, %2" : "=v"(r) : "v"(lo), "v"(hi)); return r; }
__device__ __forceinline__ float bf_lo(unsigned w) { return __uint_as_float(w << 16); }
__device__ __forceinline__ float bf_hi(unsigned w) { return __uint_as_float(w & 0xffff0000u); }
__device__ __forceinline__ int opaque_tid() { int t = threadIdx.x; asm volatile("" : "+v"(t)); return t; }
template <int X> __device__ __forceinline__ float xor_swz(float v) { return __int_as_float(__builtin_amdgcn_ds_swizzle(__float_as_int(v), (X << 10) | 0x1f)); }
__device__ __forceinline__ float wave_max(float v) {
    v = fmaxf(v, xor_swz<1>(v)); v = fmaxf(v, xor_swz<2>(v)); v = fmaxf(v, xor_swz<4>(v)); v = fmaxf(v, xor_swz<8>(v)); v = fmaxf(v, xor_swz<16>(v));
    auto rr = __builtin_amdgcn_permlane32_swap(__float_as_uint(v), __float_as_uint(v), false, false);
    return fmaxf(__uint_as_float(rr[0]), __uint_as_float(rr[1]));
}
__device__ __forceinline__ unsigned pack_i8x4(float a, float b, float c, float d) {
    const int ia = __float2int_rn(a), ib = __float2int_rn(b), ic = __float2int_rn(c), id = __float2int_rn(d);
    return (unsigned)(ia & 0xff) | ((unsigned)(ib & 0xff) << 8) | ((unsigned)(ic & 0xff) << 16) | ((unsigned)id << 24);
}
__device__ __forceinline__ float wave_sum(float v) {
    v += xor_swz<1>(v); v += xor_swz<2>(v); v += xor_swz<4>(v); v += xor_swz<8>(v); v += xor_swz<16>(v);
    auto rr = __builtin_amdgcn_permlane32_swap(__float_as_uint(v), __float_as_uint(v), false, false);
    return __uint_as_float(rr[0]) + __uint_as_float(rr[1]);
}

namespace pg8 {
#ifndef PG8_WGM
#define PG8_WGM 4
#endif
#ifndef PG8_WGM_WIDE
#define PG8_WGM_WIDE 8
#endif
constexpr int BM = 256, BK = 64, HALF = 128, HTB = HALF * BK * 2, STAGE_BYTES = 8 * HTB, NXCD = 8, WGM = PG8_WGM;
__device__ __forceinline__ int lds_byte(int r, int c) { const int st = (r >> 4) * 2 + (c >> 5), rr = r & 15, cc = c & 31, ob = rr * 64 + cc * 2; return st * 1024 + (ob ^ (((ob >> 9) & 1) << 5)); }
__device__ __forceinline__ void stage_rc(int b, int& R, int& C) { const int st = b / 1024, sb = b % 1024, swz = sb ^ (((sb >> 9) & 1) << 5); R = (st >> 1) * 16 + swz / 64; C = (st & 1) * 32 + (swz % 64) / 2; }
__device__ __forceinline__ int perm32(int rho) { const int n = rho >> 4, i = rho & 15; return 8 * (i >> 2) + 4 * n + (i & 3); }
struct Unit { int pm, pn, seg, k0, ntk, split, sl; };
struct Gemm { const void* A; const void* Bt; int M, N, PB; };
struct StaticOrder {
    int nM, nN, nwg, G, c, nMs, ntK, wgm;
    __device__ void init(int M, int N, int PB, int G_, int c_, int nMs_) { nM = M / BM - nMs_; nN = N / BM; nwg = nM * nN; G = G_; c = c_; nMs = nMs_; ntK = PB / 128; wgm = nN > 8 ? PG8_WGM_WIDE : WGM; }
    template <int SEGN> __device__ bool next(int i, Unit& u) const {
        if (SEGN > 1) { u.seg = i % SEGN; i /= SEGN; u.k0 = u.seg == 0 ? 0 : (u.seg == 1 ? 12 : 20); u.ntk = u.seg == 1 ? 8 : 12; }
        else { u.seg = 0; u.k0 = 0; u.ntk = ntK; }
        u.split = 0; u.sl = 0;
        const long L = (long)i * G + c;
        if (L < nwg) {
            int wgid = (int)L; { const int q = nwg / NXCD, r = nwg % NXCD, xcd = wgid % NXCD, off = wgid / NXCD; wgid = (xcd < r ? xcd * (q + 1) : r * (q + 1) + (xcd - r) * q) + off; }
            const int nig = wgm * nN, gid = wgid / nig, fm = gid * wgm, gsz = (nM - fm) < wgm ? (nM - fm) : wgm;
            u.pm = fm + ((wgid % nig) % gsz); u.pn = (wgid % nig) / gsz; return true;
        }
        if (SEGN > 1 || nMs == 0) return false;
        const long first = ((long)nwg + G - 1) / G * G;
        if (L < first) return false;
        const int sub = (int)(L - first), tile = sub >> 3, sl = sub & 7;
        if (tile >= nMs * nN) return false;
        u.pm = nM + tile / nN; u.pn = tile % nN; u.split = 1; u.sl = sl;
        const int pairs = ntK >> 1, base = pairs >> 3, rem = pairs & 7;
        u.ntk = 2 * (base + (sl < rem ? 1 : 0)); u.k0 = 2 * (sl * base + (sl < rem ? sl : rem));
        return true;
    }
};

struct EpiStore {
    static constexpr bool PERM = true; static constexpr int SEGN = 1;
    bf16_t* O; int ldc; int dry;
    __device__ __forceinline__ void operator()(f32x4 (&acc)[2][2][4][2], const Unit& u, int wr, int wc, int fr, int fq) const {
        if (dry) return;
        const int row0 = u.pm * BM + wr * 64 + fr, col0 = u.pn * BM + wc * 32 + 8 * fq;
#pragma unroll
        for (int ai = 0; ai < 2; ++ai)
#pragma unroll
            for (int m = 0; m < 4; ++m) { bf16_t* rowp = O + (size_t)(row0 + ai * HALF + m * 16) * ldc + col0;
#pragma unroll
                for (int bj = 0; bj < 2; ++bj) { const f32x4 v0 = acc[ai][bj][m][0], v1 = acc[ai][bj][m][1];
                    u32x4 w; w.x = cvt_pk_bf16(v0[0], v0[1]); w.y = cvt_pk_bf16(v0[2], v0[3]); w.z = cvt_pk_bf16(v1[0], v1[1]); w.w = cvt_pk_bf16(v1[2], v1[3]);
                    *(u32x4*)(rowp + bj * HALF) = w; } }
    }
};
struct EpiStoreQ {
    static constexpr bool PERM = true; static constexpr int SEGN = 1;
    bf16_t* O; int ldc; const float* rs; const float* cs; unsigned char* gt;
    __device__ __forceinline__ void operator()(f32x4 (&acc)[2][2][4][2], const Unit& u, int wr, int wc, int fr, int fq) const {
        const int row0 = u.pm * BM + wr * 64 + fr, col0 = u.pn * BM + wc * 32 + 8 * fq;
        const bool gate_tile = u.pn >= QT;
        unsigned char* gbase = gt + ((size_t)((((u.pn - QT) >> 3) * (MTOT / BM) + u.pm) * 8 + ((u.pn - QT) & 7)) << 17) + (size_t)((((wr * 4 + wc) << 6) + fq * 16 + fr) * 16);
        f32x4 cv[2][2];
#pragma unroll
        for (int bj = 0; bj < 2; ++bj)
#pragma unroll
            for (int n = 0; n < 2; ++n) cv[bj][n] = *(const f32x4*)(cs + col0 + bj * HALF + 4 * n);
#pragma unroll
        for (int ai = 0; ai < 2; ++ai)
#pragma unroll
            for (int m = 0; m < 4; ++m) { const int row = row0 + ai * HALF + m * 16; const float r = rs[row]; bf16_t* rowp = O + (size_t)row * ldc + col0;
#pragma unroll
                for (int bj = 0; bj < 2; ++bj) { const i32x4 i0 = __builtin_bit_cast(i32x4, acc[ai][bj][m][0]), i1 = __builtin_bit_cast(i32x4, acc[ai][bj][m][1]);
                    float v[8];
#pragma unroll
                    for (int j = 0; j < 4; ++j) { v[j] = (float)i0[j] * r * cv[bj][0][j]; v[4 + j] = (float)i1[j] * r * cv[bj][1][j]; }
                    u32x4 w; w.x = cvt_pk_bf16(v[0], v[1]); w.y = cvt_pk_bf16(v[2], v[3]); w.z = cvt_pk_bf16(v[4], v[5]); w.w = cvt_pk_bf16(v[6], v[7]);
                    if (gate_tile) *(u32x4*)(gbase + ((ai * 2 + bj) * 4 + m) * 8192) = w;
                    else *(u32x4*)(rowp + bj * HALF) = w; } }
    }
};
struct EpiResid {
    static constexpr bool PERM = false; static constexpr int SEGN = 1;
    float* xlat; float* xctx; const float* slat; const float* sctx; const float* modv; float* part; int dry;
    __device__ __forceinline__ void operator()(f32x4 (&acc)[2][2][4][2], const Unit& u, int wr, int wc, int fr, int fq) const {
        if (dry) return;
        const int set = u.pm < (MLAT / BM) ? (u.pm >> 4) : 4;
        float* xb = u.pm < (MLAT / BM) ? xlat + (size_t)u.pm * BM * DM : xctx + (size_t)(u.pm - MLAT / BM) * BM * DM;
        const float* sb = u.pm < (MLAT / BM) ? slat + (size_t)u.pm * BM * DM : sctx + (size_t)(u.pm - MLAT / BM) * BM * DM;
        float* pp = part + ((size_t)u.sl * MCTX + (size_t)(u.pm - MLAT / BM) * BM) * DM;
        const int col0 = u.pn * BM + wc * 32 + 4 * fq;
        const float* mp = modv + (size_t)set * 6 * DM + col0;
        f32x4 mv[2][2];
#pragma unroll
        for (int bj = 0; bj < 2; ++bj)
#pragma unroll
            for (int n = 0; n < 2; ++n) mv[bj][n] = *(const f32x4*)(mp + bj * HALF + n * 16);
        if (u.split) {
#pragma unroll
            for (int ai = 0; ai < 2; ++ai)
#pragma unroll
                for (int m = 0; m < 4; ++m) { const size_t ro = (size_t)(ai * HALF + wr * 64 + m * 16 + fr) * DM + col0;
#pragma unroll
                    for (int bj = 0; bj < 2; ++bj)
#pragma unroll
                        for (int n = 0; n < 2; ++n) *(f32x4*)(pp + ro + bj * HALF + n * 16) = mv[bj][n] * acc[ai][bj][m][n]; }
            return;
        }
#pragma unroll
        for (int ai = 0; ai < 2; ++ai) {
            f32x4 xv[4][2][2];
#pragma unroll
            for (int m = 0; m < 4; ++m) { const float* srcp = sb + (size_t)(ai * HALF + wr * 64 + m * 16 + fr) * DM + col0;
#pragma unroll
                for (int bj = 0; bj < 2; ++bj)
#pragma unroll
                    for (int n = 0; n < 2; ++n) xv[m][bj][n] = *(const f32x4*)(srcp + bj * HALF + n * 16); }
#pragma unroll
            for (int m = 0; m < 4; ++m) { float* rowp = xb + (size_t)(ai * HALF + wr * 64 + m * 16 + fr) * DM + col0;
#pragma unroll
                for (int bj = 0; bj < 2; ++bj)
#pragma unroll
                    for (int n = 0; n < 2; ++n) *(f32x4*)(rowp + bj * HALF + n * 16) = xv[m][bj][n] + mv[bj][n] * acc[ai][bj][m][n]; }
            asm volatile("" ::: "memory"); }
    }
};
struct EpiBranch {
    static constexpr bool PERM = true; static constexpr int SEGN = 3;
    const unsigned char* gt; bf16_t* O; int dry;
    __device__ __forceinline__ const unsigned char* gtile(int g, const Unit& u, int wr, int wc, int fr, int fq) const { return gt + ((size_t)((g * (MTOT / BM) + u.pm) * 8 + u.pn) << 17) + (size_t)((((wr * 4 + wc) << 6) + fq * 16 + fr) * 16); }
    __device__ __forceinline__ void rescale(f32x4 (&acc)[2][2][4][2], const Unit& u, int which, int wr, int wc, int fr, int fq) const {
        const unsigned char* p1 = gtile(which, u, wr, wc, fr, fq); const unsigned char* p2 = gtile(which + 1, u, wr, wc, fr, fq);
#pragma unroll
        for (int ai = 0; ai < 2; ++ai) {
            u32x4 g1v[4][2], g2v[4][2];
#pragma unroll
            for (int m = 0; m < 4; ++m) {
#pragma unroll
                for (int bj = 0; bj < 2; ++bj) { g1v[m][bj] = *(const u32x4*)(p1 + ((ai * 2 + bj) * 4 + m) * 8192); g2v[m][bj] = *(const u32x4*)(p2 + ((ai * 2 + bj) * 4 + m) * 8192); } }
#pragma unroll
            for (int m = 0; m < 4; ++m) {
#pragma unroll
                for (int bj = 0; bj < 2; ++bj) { const u32x4 g1 = g1v[m][bj], g2 = g2v[m][bj];
#pragma unroll
                    for (int q = 0; q < 4; ++q) { const float a0 = bf_lo(g1[q]), a1 = bf_hi(g1[q]), b0 = bf_lo(g2[q]), b1 = bf_hi(g2[q]);
                        const float r0 = (1.f + __expf(-b0)) * __builtin_amdgcn_rcpf(1.f + __expf(-a0)), r1 = (1.f + __expf(-b1)) * __builtin_amdgcn_rcpf(1.f + __expf(-a1));
                        acc[ai][bj][m][q >> 1][(q & 1) * 2] *= r0; acc[ai][bj][m][q >> 1][(q & 1) * 2 + 1] *= r1; } } }
            asm volatile("" ::: "memory"); }
    }
    __device__ __forceinline__ void operator()(f32x4 (&acc)[2][2][4][2], const Unit& u, int wr, int wc, int fr, int fq) const {
        if (dry) return;
        if (u.seg < 2) { rescale(acc, u, u.seg, wr, wc, fr, fq); return; }
        const int row0 = u.pm * BM + wr * 64 + fr, col0 = u.pn * BM + wc * 32 + 8 * fq;
        const unsigned char* p3 = gtile(2, u, wr, wc, fr, fq);
#pragma unroll
        for (int ai = 0; ai < 2; ++ai) {
            u32x4 gv[4][2];
#pragma unroll
            for (int m = 0; m < 4; ++m) {
#pragma unroll
                for (int bj = 0; bj < 2; ++bj) gv[m][bj] = *(const u32x4*)(p3 + ((ai * 2 + bj) * 4 + m) * 8192); }
#pragma unroll
            for (int m = 0; m < 4; ++m) { bf16_t* rowp = O + (size_t)(row0 + ai * HALF + m * 16) * DM + col0;
#pragma unroll
                for (int bj = 0; bj < 2; ++bj) { const u32x4 g = gv[m][bj]; float v[8];
#pragma unroll
                    for (int q = 0; q < 4; ++q) { const float s0 = __builtin_amdgcn_rcpf(1.f + __expf(-bf_lo(g[q]))), s1 = __builtin_amdgcn_rcpf(1.f + __expf(-bf_hi(g[q])));
                        v[2 * q] = acc[ai][bj][m][q >> 1][(q & 1) * 2] * s0; v[2 * q + 1] = acc[ai][bj][m][q >> 1][(q & 1) * 2 + 1] * s1; }
                    u32x4 w; w.x = cvt_pk_bf16(v[0], v[1]); w.y = cvt_pk_bf16(v[2], v[3]); w.z = cvt_pk_bf16(v[4], v[5]); w.w = cvt_pk_bf16(v[6], v[7]);
                    *(u32x4*)(rowp + bj * HALF) = w; } }
            asm volatile("" ::: "memory"); }
    }
};

template <int CTRL> __device__ __forceinline__ float dppf(float x) { return __int_as_float(__builtin_amdgcn_update_dpp(0, __float_as_int(x), CTRL, 0xf, 0xf, false)); }
template <bool Q> struct EpiGLU {
    static constexpr bool PERM = true; static constexpr int SEGN = 1;
    bf16_t* G; const float* cw; const float* cb; float* ES; float* EA; float* EU; int dry; const float* rs; const float* cs;
    __device__ __forceinline__ void operator()(f32x4 (&acc)[2][2][4][2], const Unit& u, int wr, int wc, int fr, int fq) const {
        if (dry) return;
        const int colg = u.pn * 128 + wc * 32 + 8 * fq;
        if constexpr (Q) {
            const int ct = u.pn * BM + wc * 32 + 8 * fq;
            f32x4 cv[2][2];
#pragma unroll
            for (int bj = 0; bj < 2; ++bj)
#pragma unroll
                for (int n = 0; n < 2; ++n) cv[bj][n] = *(const f32x4*)(cs + ct + bj * HALF + 4 * n);
#pragma unroll
            for (int ai = 0; ai < 2; ++ai)
#pragma unroll
                for (int m = 0; m < 4; ++m) { const float r = rs[u.pm * BM + ai * HALF + wr * 64 + m * 16 + fr];
#pragma unroll
                    for (int bj = 0; bj < 2; ++bj)
#pragma unroll
                        for (int n = 0; n < 2; ++n) { const i32x4 iv = __builtin_bit_cast(i32x4, acc[ai][bj][m][n]);
#pragma unroll
                            for (int j = 0; j < 4; ++j) acc[ai][bj][m][n][j] = (float)iv[j] * r * cv[bj][n][j]; } }
        }
        float w0[8], w1[8], w2[8], bb[8];
#pragma unroll
        for (int h = 0; h < 2; ++h) { const f32x4 a0 = *(const f32x4*)(cw + colg + 4 * h), a1 = *(const f32x4*)(cw + DFF + colg + 4 * h), a2 = *(const f32x4*)(cw + 2 * DFF + colg + 4 * h), a3 = *(const f32x4*)(cb + colg + 4 * h);
#pragma unroll
            for (int i = 0; i < 4; ++i) { w0[4 * h + i] = a0[i]; w1[4 * h + i] = a1[i]; w2[4 * h + i] = a2[i]; bb[4 * h + i] = a3[i]; } }
#pragma unroll
        for (int ai = 0; ai < 2; ++ai) {
            const int blk = 4 * u.pm + 2 * ai + wr;
#pragma unroll
            for (int m = 0; m < 4; ++m) {
                float g[8], sv[8];
#pragma unroll
                for (int e = 0; e < 8; ++e) { const int n = e >> 2, j = e & 3;
                    const float a = acc[ai][0][m][n][j], uu = acc[ai][1][m][n][j];
                    const float tp = (m > 0 && fr == 15) ? acc[ai][0][m > 0 ? m - 1 : 0][n][j] : a;
                    const float tn = (m < 3 && fr == 0) ? acc[ai][0][m < 3 ? m + 1 : 3][n][j] : a;
                    float prev = dppf<0x121>(tp), next = dppf<0x12F>(tn);
                    if (m == 0 && fr == 0) prev = 0.f;
                    if (m == 3 && fr == 15) next = 0.f;
                    const float v = w0[e] * prev + w1[e] * a + w2[e] * next + bb[e];
                    sv[e] = v; g[e] = v * __builtin_amdgcn_rcpf(1.f + __expf(-v)) * uu; }
                const int row = u.pm * BM + ai * HALF + wr * 64 + m * 16 + fr;
                u32x4 w; w.x = cvt_pk_bf16(g[0], g[1]); w.y = cvt_pk_bf16(g[2], g[3]); w.z = cvt_pk_bf16(g[4], g[5]); w.w = cvt_pk_bf16(g[6], g[7]);
                *(u32x4*)(G + (size_t)row * DFF + colg) = w;
                if ((m == 0 && fr == 0) || (m == 3 && fr == 15)) {
                    const size_t eo = ((size_t)blk * 2 + (m == 0 ? 0 : 1)) * DFF + colg;
#pragma unroll
                    for (int h = 0; h < 2; ++h) {
                        *(f32x4*)(ES + eo + 4 * h) = (f32x4){sv[4 * h], sv[4 * h + 1], sv[4 * h + 2], sv[4 * h + 3]};
                        *(f32x4*)(EA + eo + 4 * h) = acc[ai][0][m][h];
                        *(f32x4*)(EU + eo + 4 * h) = acc[ai][1][m][h]; }
                }
                asm volatile("" ::: "memory");
            }
        }
    }
};

#ifndef PG8_SP2
#define PG8_SP2 true
#endif
#ifndef PG8_ALIGN
#define PG8_ALIGN true
#endif
template <class Epi, bool I8 = false, bool ALIGN_EPI = PG8_ALIGN, bool SP2 = PG8_SP2>
__device__ __forceinline__ void gemm_phase(LAS unsigned char* lds, const Gemm g, const StaticOrder& S, const Epi& E) {
    const int tid = opaque_tid(), wid = __builtin_amdgcn_readfirstlane(tid >> 6), lane = tid & 63, wr = wid >> 2, wc = wid & 3, fr = lane & 15, fq = lane >> 4;
    const int PB = g.PB;
    unsigned voffA[2], voffB[2];
#pragma unroll
    for (int i = 0; i < 2; ++i) { int R, C; stage_rc(tid * 16 + i * 8192, R, C); const int Rb = Epi::PERM ? ((R & ~31) + perm32(R & 31)) : R;
        voffA[i] = (unsigned)(R * PB + C * 2); voffB[i] = (unsigned)(Rb * PB + C * 2); }
    const size_t kstep = (size_t)(BK * 2);
    const size_t hstep = (size_t)HALF * PB;
    const size_t tstep = 2 * hstep;
    const unsigned ldsw = (unsigned)wid * 1024u;
    const int aoff = lds_byte(wr * 64 + fr, fq * 8), boff = lds_byte(wc * 32 + fr, fq * 8);
#define PG8_SA(b, h) (((b) * 2 + (h)) * HTB)
#define PG8_SB(b, h) ((4 + (b) * 2 + (h)) * HTB)
#define PG8_STAGE(bufoff, gbase, voff) do { _Pragma("unroll") for (int _i = 0; _i < 2; ++_i) \
        __builtin_amdgcn_global_load_lds((const unsigned*)((const char*)(gbase) + (voff)[_i]), (LAS unsigned*)(lds + (bufoff) + ldsw + _i * 8192), 16, 0, 0); } while (0)
#define PG8_LDA(dst, b, h) do { _Pragma("unroll") for (int m = 0; m < 4; ++m) _Pragma("unroll") for (int k = 0; k < 2; ++k) dst[m][k] = *(const LAS bf16x8*)(lds + PG8_SA(b, h) + aoff + m * 2048 + k * 1024); } while (0)
#define PG8_LDB(dst, b, h) do { _Pragma("unroll") for (int n = 0; n < 2; ++n) _Pragma("unroll") for (int k = 0; k < 2; ++k) dst[n][k] = *(const LAS bf16x8*)(lds + PG8_SB(b, h) + boff + n * 2048 + k * 1024); } while (0)
#define PG8_MMA(ai, bj, At, Bt) do { __builtin_amdgcn_s_setprio(1); _Pragma("unroll") for (int m = 0; m < 4; ++m) _Pragma("unroll") for (int n = 0; n < 2; ++n) _Pragma("unroll") for (int k = 0; k < 2; ++k) \
        { if constexpr (I8) acc[ai][bj][m][n] = __builtin_bit_cast(f32x4, __builtin_amdgcn_mfma_i32_16x16x64_i8(__builtin_bit_cast(i32x4, Bt[n][k]), __builtin_bit_cast(i32x4, At[m][k]), __builtin_bit_cast(i32x4, acc[ai][bj][m][n]), 0, 0, 0)); \
          else acc[ai][bj][m][n] = __builtin_amdgcn_mfma_f32_16x16x32_bf16(Bt[n][k], At[m][k], acc[ai][bj][m][n], 0, 0, 0); } __builtin_amdgcn_s_setprio(0); } while (0)
#define PG8_WAIT_V(n) asm volatile("s_waitcnt vmcnt(" #n ")" ::: "memory")
#define PG8_WAIT_L(n) asm volatile("s_waitcnt lgkmcnt(" #n ")" ::: "memory")
#define PG8_BAR __builtin_amdgcn_s_barrier()
#define PG8_SCHED __builtin_amdgcn_sched_barrier(0)
    constexpr int SEGN = Epi::SEGN;
    Unit cur, nxt; int ui = 0;
    if (!S.template next<SEGN>(0, cur)) return;
    f32x4 acc[2][2][4][2];
#pragma unroll
    for (int a = 0; a < 2; ++a)
#pragma unroll
        for (int b = 0; b < 2; ++b)
#pragma unroll
            for (int m = 0; m < 4; ++m)
#pragma unroll
                for (int n = 0; n < 2; ++n) acc[a][b][m][n] = (f32x4){0.f, 0.f, 0.f, 0.f};
    bf16x8 At[4][2], B0[2][2], B1[2][2];
    const char* cA = (const char*)g.A + (size_t)cur.pm * tstep + (size_t)cur.k0 * kstep; const char* cB = (const char*)g.Bt + (size_t)cur.pn * tstep + (size_t)cur.k0 * kstep;
    if constexpr (SP2) {
        PG8_STAGE(PG8_SB(0, 0), cB, voffB); PG8_STAGE(PG8_SB(0, 1), cB + hstep, voffB); PG8_STAGE(PG8_SA(0, 0), cA, voffA); PG8_STAGE(PG8_SA(0, 1), cA + hstep, voffA);
        if (wr == 1) PG8_BAR;
        PG8_WAIT_V(2); PG8_BAR;
        PG8_STAGE(PG8_SB(1, 0), cB + kstep, voffB); PG8_STAGE(PG8_SA(1, 0), cA + kstep, voffA); PG8_STAGE(PG8_SB(1, 1), cB + hstep + kstep, voffB);
        PG8_WAIT_V(6); PG8_BAR;
    } else {
    PG8_STAGE(PG8_SB(0, 0), cB, voffB); PG8_STAGE(PG8_SA(0, 0), cA, voffA); PG8_STAGE(PG8_SB(0, 1), cB + hstep, voffB); PG8_STAGE(PG8_SA(0, 1), cA + hstep, voffA);
    if (wr == 1) PG8_BAR;
    PG8_WAIT_V(4); PG8_BAR;
    PG8_STAGE(PG8_SB(1, 0), cB + kstep, voffB); PG8_STAGE(PG8_SA(1, 0), cA + kstep, voffA); PG8_STAGE(PG8_SB(1, 1), cB + hstep + kstep, voffB);
    PG8_WAIT_V(6); PG8_BAR;
    }
    for (;;) {
        const bool has_next = S.template next<SEGN>(ui + 1, nxt);
        const char* nA = has_next ? (const char*)g.A + (size_t)nxt.pm * tstep + (size_t)nxt.k0 * kstep : cA; const char* nB = has_next ? (const char*)g.Bt + (size_t)nxt.pn * tstep + (size_t)nxt.k0 * kstep : cB;
        const int ntc = cur.ntk;
        for (int t = 0; t < ntc; t += 2) {
            const bool last = (t == ntc - 2);
            const char* a1 = cA + (size_t)(t + 1) * kstep;
            const char* a2 = last ? nA : cA + (size_t)(t + 2) * kstep; const char* b2 = last ? nB : cB + (size_t)(t + 2) * kstep;
            const char* a3 = a2 + kstep; const char* b3 = b2 + kstep;
            if constexpr (SP2) {
            PG8_LDB(B0, 0, 0); PG8_LDB(B1, 0, 1); PG8_SCHED; PG8_LDA(At, 0, 0); PG8_STAGE(PG8_SA(1, 1), a1 + hstep, voffA);
            PG8_WAIT_V(8); PG8_WAIT_L(0); PG8_BAR; PG8_MMA(0, 0, At, B0); PG8_MMA(0, 1, At, B1); PG8_BAR; PG8_SCHED;
            PG8_LDA(At, 0, 1); PG8_STAGE(PG8_SB(0, 0), b2, voffB); PG8_STAGE(PG8_SB(0, 1), b2 + hstep, voffB); PG8_STAGE(PG8_SA(0, 0), a2, voffA);
            PG8_WAIT_V(8); PG8_WAIT_L(0); PG8_BAR; PG8_MMA(1, 0, At, B0); PG8_MMA(1, 1, At, B1); PG8_BAR; PG8_SCHED;
            PG8_LDB(B0, 1, 0); PG8_LDB(B1, 1, 1); PG8_SCHED; PG8_LDA(At, 1, 0); PG8_STAGE(PG8_SA(0, 1), a2 + hstep, voffA);
            PG8_WAIT_V(8); PG8_WAIT_L(0); PG8_BAR; PG8_MMA(0, 0, At, B0); PG8_MMA(0, 1, At, B1); PG8_BAR; PG8_SCHED;
            PG8_LDA(At, 1, 1); PG8_STAGE(PG8_SB(1, 0), b3, voffB); PG8_STAGE(PG8_SB(1, 1), b3 + hstep, voffB); PG8_STAGE(PG8_SA(1, 0), a3, voffA);
            PG8_WAIT_V(8); PG8_WAIT_L(0); PG8_BAR; PG8_MMA(1, 0, At, B0); PG8_MMA(1, 1, At, B1); PG8_BAR; PG8_SCHED;
            } else {
            PG8_LDB(B0, 0, 0); PG8_SCHED; PG8_LDA(At, 0, 0); PG8_STAGE(PG8_SA(1, 1), a1 + hstep, voffA);
            PG8_WAIT_L(8); PG8_BAR; PG8_WAIT_L(0); PG8_MMA(0, 0, At, B0); PG8_BAR; PG8_SCHED;
            PG8_LDB(B1, 0, 1); PG8_STAGE(PG8_SB(0, 0), b2, voffB);
            PG8_BAR; PG8_WAIT_L(0); PG8_MMA(0, 1, At, B1); PG8_BAR;
            PG8_LDA(At, 0, 1); PG8_STAGE(PG8_SA(0, 0), a2, voffA);
            PG8_BAR; PG8_WAIT_L(0); PG8_MMA(1, 0, At, B0); PG8_BAR; PG8_SCHED;
            PG8_STAGE(PG8_SB(0, 1), b2 + hstep, voffB);
            PG8_WAIT_V(6); PG8_BAR; PG8_MMA(1, 1, At, B1); PG8_BAR;
            PG8_LDB(B0, 1, 0); PG8_SCHED; PG8_LDA(At, 1, 0); PG8_STAGE(PG8_SA(0, 1), a2 + hstep, voffA);
            PG8_WAIT_L(8); PG8_BAR; PG8_WAIT_L(0); PG8_MMA(0, 0, At, B0); PG8_BAR; PG8_SCHED;
            PG8_LDB(B1, 1, 1); PG8_STAGE(PG8_SB(1, 0), b3, voffB);
            PG8_BAR; PG8_WAIT_L(0); PG8_MMA(0, 1, At, B1); PG8_BAR;
            PG8_LDA(At, 1, 1); PG8_STAGE(PG8_SA(1, 0), a3, voffA);
            PG8_BAR; PG8_WAIT_L(0); PG8_MMA(1, 0, At, B0); PG8_BAR; PG8_SCHED;
            PG8_STAGE(PG8_SB(1, 1), b3 + hstep, voffB);
            PG8_WAIT_V(6); PG8_BAR; PG8_MMA(1, 1, At, B1); PG8_BAR;
            }
        }
        if constexpr (ALIGN_EPI) { if (wr == 0) PG8_BAR; }
        E(acc, cur, wr, wc, fr, fq);
        if (!has_next) break;
        if (SEGN == 1 || cur.seg == SEGN - 1) {
#pragma unroll
        for (int a = 0; a < 2; ++a)
#pragma unroll
            for (int b = 0; b < 2; ++b)
#pragma unroll
                for (int m = 0; m < 4; ++m)
#pragma unroll
                    for (int n = 0; n < 2; ++n) acc[a][b][m][n] = (f32x4){0.f, 0.f, 0.f, 0.f};
        }
        cur = nxt; cA = nA; cB = nB; ++ui;
        if constexpr (ALIGN_EPI) { if (wr == 1) PG8_BAR; }
    }
    PG8_WAIT_V(0);
    if constexpr (!ALIGN_EPI) { if (wr == 0) PG8_BAR; }
    PG8_BAR;
#undef PG8_SA
#undef PG8_SB
#undef PG8_STAGE
#undef PG8_LDA
#undef PG8_LDB
#undef PG8_MMA
#undef PG8_WAIT_V
#undef PG8_WAIT_L
#undef PG8_BAR
#undef PG8_SCHED
}
}

namespace att {
constexpr int D = 128, NW = 8, QBLK = 32, KVBLK = 64;
constexpr float SCALE = 0.088388347648318440f;
constexpr float THR = 8.f;
#ifndef ATT_SDEPTH
#define ATT_SDEPTH 1
#endif
constexpr int SDEPTH = ATT_SDEPTH;
constexpr int LDQ = QP, LDK = QP, LDO = DM;
constexpr size_t SHM_V = KVBLK * D * 2, SHM_K = KVBLK * D * 2, SHM_ATTN = 2 * SHM_V + 2 * SHM_K + NW * 64 * 4;
constexpr int BTAB_OFF = (int)SHM_ATTN;
constexpr int RTAB_OFF = BTAB_OFF + 2048;
#define KSWZ(row, colB) ((row) * 256 + ((colB) ^ (((row) & 7) << 4)))
#define SBAR() __builtin_amdgcn_sched_barrier(0)
__device__ __forceinline__ int crow(int r, int hi) { return (r & 3) + 8 * (r >> 2) + 4 * hi; }

struct Args {
    const bf16_t* Qb;
    const bf16_t* Kb;
    const bf16_t* Vb;
    bf16_t* Ob;
    int ctx_row0, lat_row0, NT;
    float sink_l2;
    int abase;
    int b_r0, b_rs0;
    const float* qg;
    int q_rope, q_t0;
};

__device__ __forceinline__ void partialSM(f32x16& p0, f32x16& p1, float& m_reg, float& mn, float& alpha) {
    constexpr float C = SCALE * 1.4426950408889634f;
    float pmax = p0[0];
#pragma unroll
    for (int r = 1; r < 16; ++r) pmax = fmaxf(pmax, p0[r]);
#pragma unroll
    for (int r = 0; r < 16; ++r) pmax = fmaxf(pmax, p1[r]);
    { auto rr = __builtin_amdgcn_permlane32_swap(__float_as_uint(pmax), __float_as_uint(pmax), false, false);
      pmax = fmaxf(__uint_as_float(rr[0]), __uint_as_float(rr[1])); }
    if (__builtin_expect(__all(pmax - m_reg <= THR / SCALE), 1)) { mn = m_reg; alpha = 1.f; }
    else { mn = fmaxf(m_reg, pmax); alpha = __builtin_amdgcn_exp2f((m_reg - mn) * C); m_reg = mn; }
    float mnC = -mn * C;
#pragma unroll
    for (int r = 0; r < 16; ++r) p0[r] = fmaf(p0[r], C, mnC);
#pragma unroll
    for (int r = 0; r < 16; ++r) p1[r] = fmaf(p1[r], C, mnC);
#pragma unroll
    for (int r = 0; r < 16; ++r) p0[r] = __builtin_amdgcn_exp2f(p0[r]);
}
__device__ __forceinline__ void finishSM(f32x16& p0, f32x16& p1, float alpha, float& l_reg, bf16x8& pa0, bf16x8& pa1, bf16x8& pa2, bf16x8& pa3) {
#pragma unroll
    for (int r = 0; r < 16; ++r) p1[r] = __builtin_amdgcn_exp2f(p1[r]);
    float ps = 0;
#pragma unroll
    for (int r = 0; r < 16; ++r) ps += p0[r];
#pragma unroll
    for (int r = 0; r < 16; ++r) ps += p1[r];
    { auto rr = __builtin_amdgcn_permlane32_swap(__float_as_uint(ps), __float_as_uint(ps), false, false);
      ps = __uint_as_float(rr[0]) + __uint_as_float(rr[1]); }
    l_reg = l_reg * alpha + ps;
#define PK4(P, BASE, OUT) do { unsigned a0 = cvt_pk_bf16(P[BASE + 0], P[BASE + 1]), a1 = cvt_pk_bf16(P[BASE + 2], P[BASE + 3]);   \
    unsigned b0 = cvt_pk_bf16(P[BASE + 4], P[BASE + 5]), b1 = cvt_pk_bf16(P[BASE + 6], P[BASE + 7]);                              \
    auto r0 = __builtin_amdgcn_permlane32_swap(a0, b0, false, false); auto r1 = __builtin_amdgcn_permlane32_swap(a1, b1, false, false); \
    u32x4 w = {r0[0], r1[0], r0[1], r1[1]}; OUT = *reinterpret_cast<bf16x8*>(&w); } while (0)
    PK4(p0, 0, pa0); PK4(p0, 8, pa1); PK4(p1, 0, pa2); PK4(p1, 8, pa3);
#undef PK4
}
__device__ __forceinline__ void qkt(f32x16& p0, f32x16& p1, const char* Ks, const bf16x8* qr, int r32, int hi) {
    p0 = f32x16{}; p1 = f32x16{};
#pragma unroll
    for (int d0 = 0; d0 < 8; ++d0) { int cb = (d0 * 16 + hi * 8) * 2;
        bf16x8 b0 = *reinterpret_cast<const bf16x8*>(Ks + KSWZ(r32, cb));
        bf16x8 b1 = *reinterpret_cast<const bf16x8*>(Ks + KSWZ(32 + r32, cb));
        p0 = __builtin_amdgcn_mfma_f32_32x32x16_bf16(b0, qr[d0], p0, 0, 0, 0);
        p1 = __builtin_amdgcn_mfma_f32_32x32x16_bf16(b1, qr[d0], p1, 0, 0, 0); }
}
__device__ __forceinline__ int v_st(int k, int c) { const int kk = (k & ~0xC) | ((k & 4) << 1) | ((k & 8) >> 1); return ((kk >> 3) * 4 + (c >> 5)) * 512 + ((kk & 7) * 32 + (c & 31)) * 2; }
__device__ __forceinline__ int v_rd_base(int lane) { return ((lane & 3) << 3) | (((lane >> 2) & 3) << 6) | (((lane >> 4) & 1) << 5) | (((lane >> 5) & 1) << 8); }
constexpr int v_rd_off(int d0, int ks, int half) { return d0 * 512 + ks * 4096 + half * 2048; }
template <int OFF> __device__ __forceinline__ s16x4 tr_read(int vb) {
    s16x4 r; asm volatile("ds_read_b64_tr_b16 %0, %1 offset:%2" : "=&v"(r) : "v"(vb), "i"(OFF) : "memory"); return r;
}
template <int D0> __device__ __forceinline__ void pv_one(f32x16& od, int vb, bf16x8 pa0, bf16x8 pa1, bf16x8 pa2, bf16x8 pa3) {
    const s16x4 l0 = tr_read<v_rd_off(D0, 0, 0)>(vb), h0 = tr_read<v_rd_off(D0, 0, 1)>(vb), l1 = tr_read<v_rd_off(D0, 1, 0)>(vb), h1 = tr_read<v_rd_off(D0, 1, 1)>(vb);
    const s16x4 l2 = tr_read<v_rd_off(D0, 2, 0)>(vb), h2 = tr_read<v_rd_off(D0, 2, 1)>(vb), l3 = tr_read<v_rd_off(D0, 3, 0)>(vb), h3 = tr_read<v_rd_off(D0, 3, 1)>(vb);
    asm volatile("s_waitcnt lgkmcnt(0)" ::: "memory"); SBAR();
#define PK(L, H) (bf16x8){L[0], L[1], L[2], L[3], H[0], H[1], H[2], H[3]}
    od = __builtin_amdgcn_mfma_f32_32x32x16_bf16(pa0, PK(l0, h0), od, 0, 0, 0);
    od = __builtin_amdgcn_mfma_f32_32x32x16_bf16(pa1, PK(l1, h1), od, 0, 0, 0);
    od = __builtin_amdgcn_mfma_f32_32x32x16_bf16(pa2, PK(l2, h2), od, 0, 0, 0);
    od = __builtin_amdgcn_mfma_f32_32x32x16_bf16(pa3, PK(l3, h3), od, 0, 0, 0);
#undef PK
}
__device__ __forceinline__ void pv_d0(f32x16* o, int vb, bf16x8 pa0, bf16x8 pa1, bf16x8 pa2, bf16x8 pa3) {
    pv_one<0>(o[0], vb, pa0, pa1, pa2, pa3); pv_one<1>(o[1], vb, pa0, pa1, pa2, pa3); pv_one<2>(o[2], vb, pa0, pa1, pa2, pa3); pv_one<3>(o[3], vb, pa0, pa1, pa2, pa3);
}

#ifndef SKIP_A
#define SKIP_A 1
#endif
#ifndef SKIP_B
#define SKIP_B 0
#endif
template <int MODE>
__device__ __forceinline__ void apply_mask(f32x16& p0, f32x16& p1, int j, const Args& a, int wid, int r32, int hi, const float* btab) {
    if constexpr (MODE == 1) {
        if (j >= 4) {
            const int baseW = a.abase + 64 * (j - 4) - 32 * wid;
            if (!(baseW - 31 >= -128 && baseW + 63 <= 128)) {
                const int base = baseW - r32;
#pragma unroll
                for (int r = 0; r < 16; ++r) { const int d0 = base + crow(r, hi), d1 = d0 + 32;
                    if (d0 < -128 || d0 > 128) p0[r] = -1e30f;
                    if (d1 < -128 || d1 > 128) p1[r] = -1e30f; }
            }
        }
    } else if constexpr (MODE == 2) {
        if (j >= 4) {
            const int kr = a.b_rs0 + (j - 4), qr = a.b_r0 + (wid >> 1);
            const int rs = min(max(qr - 4, 0), 56);
            if (!SKIP_B && (kr < rs || kr >= rs + 8)) {
#pragma unroll
                for (int r = 0; r < 16; ++r) { p0[r] = -1e30f; p1[r] = -1e30f; }
            } else {
                const int qc = (wid & 1) * 32 + r32, cs = min(max(qc - 8, 0), 48);
                const float* tb = btab + (kr - qr + 7) * 31;
#pragma unroll
                for (int r = 0; r < 16; ++r) { const int k0 = crow(r, hi), k1 = k0 + 32;
                    const float b0 = tb[min(max(k0 - qc + 15, 0), 30)], b1 = tb[min(max(k1 - qc + 15, 0), 30)];
                    p0[r] = (k0 >= cs && k0 < cs + 16) ? p0[r] + b0 : -1e30f;
                    p1[r] = (k1 >= cs && k1 < cs + 16) ? p1[r] + b1 : -1e30f;
                    if ((r & 3) == 3) asm volatile("" ::: "memory"); }
            }
        }
    }
}

template <int MODE>
__device__ __forceinline__ bool tile_dead(int j, const Args& a, int wid) {
    if constexpr (MODE == 1 && SKIP_A) { if (j < 4) return false; const int baseW = a.abase + 64 * (j - 4) - 32 * wid; return (baseW - 31 > 128) || (baseW + 63 < -128); }
    else if constexpr (MODE == 2 && SKIP_B) { if (j < 4) return false; const int kr = a.b_rs0 + (j - 4), qr = a.b_r0 + (wid >> 1), rs = min(max(qr - 4, 0), 56); return kr < rs || kr >= rs + 8; }
    else return false;
}
template <int MODE>
__device__ __forceinline__ void attn_body(const Args& a, char* lds) {
    const int tid = opaque_tid(), wid = __builtin_amdgcn_readfirstlane(tid >> 6), lane = tid & 63, r32 = lane & 31, hi = lane >> 5;
    char* V_lds = lds; char* K_lds = lds + 2 * SHM_V;
    float* ws = (float*)(lds + 2 * SHM_V + 2 * SHM_K) + wid * 64; float* li_l = ws; float* al_l = ws + 32;
    const float* btab = (const float*)(lds + BTAB_OFF);
    float m_reg = -1e30f, l_reg = 0; f32x16 o[4] = {}; bf16x8 qr[8];
    const bf16_t* Qw = a.Qb + (long)(wid * QBLK + r32) * LDQ + hi * 8;
#pragma unroll
    for (int d0 = 0; d0 < 8; ++d0) qr[d0] = *reinterpret_cast<const bf16x8*>(Qw + d0 * 16);
    if (a.qg != nullptr || a.q_rope) {
        float q[8][8];
#pragma unroll
        for (int d0 = 0; d0 < 8; ++d0) { const u32x4 w = *reinterpret_cast<const u32x4*>(&qr[d0]);
#pragma unroll
            for (int c = 0; c < 4; ++c) { q[d0][2 * c] = bf_lo(w[c]); q[d0][2 * c + 1] = bf_hi(w[c]); } }
        if (a.qg != nullptr) {
            float ss = 0.f;
#pragma unroll
            for (int d0 = 0; d0 < 8; ++d0)
#pragma unroll
                for (int i = 0; i < 8; ++i) ss += q[d0][i] * q[d0][i];
            { auto rr = __builtin_amdgcn_permlane32_swap(__float_as_uint(ss), __float_as_uint(ss), false, false); ss = __uint_as_float(rr[0]) + __uint_as_float(rr[1]); }
            const float rstd = rsqrtf(ss * (1.f / 128.f) + EPS);
#pragma unroll
            for (int d0 = 0; d0 < 8; ++d0) { const f32x4 g0 = *(const f32x4*)(a.qg + d0 * 16 + hi * 8), g1 = *(const f32x4*)(a.qg + d0 * 16 + hi * 8 + 4);
#pragma unroll
                for (int i = 0; i < 4; ++i) { q[d0][i] *= rstd * g0[i]; q[d0][4 + i] *= rstd * g1[i]; } }
        }
        if (a.q_rope) {
            const float2* rtab = (const float2*)(lds + RTAB_OFF);
            const int t = a.q_t0 + wid * QBLK + r32;
#pragma unroll
            for (int hb = 0; hb < 2; ++hb) { const int pos = hb ? (t & 63) : (t >> 6);
#pragma unroll
                for (int dd = 0; dd < 2; ++dd) { const int d0 = hb * 4 + dd;
#pragma unroll
                    for (int i = 0; i < 8; ++i) { const float2 cs = rtab[pos * 32 + dd * 16 + hi * 8 + i]; const float x1 = q[d0][i], x2 = q[d0 + 2][i];
                        q[d0][i] = x1 * cs.x - x2 * cs.y; q[d0 + 2][i] = x2 * cs.x + x1 * cs.y; } } }
        }
#pragma unroll
        for (int d0 = 0; d0 < 8; ++d0) { u32x4 w; w.x = cvt_pk_bf16(q[d0][0], q[d0][1]); w.y = cvt_pk_bf16(q[d0][2], q[d0][3]); w.z = cvt_pk_bf16(q[d0][4], q[d0][5]); w.w = cvt_pk_bf16(q[d0][6], q[d0][7]);
            qr[d0] = *reinterpret_cast<bf16x8*>(&w); }
    }
    const int sr = tid >> 4, sc = (tid & 15) * 8, vst0 = v_st(sr, sc), vst1 = v_st(32 + sr, sc);
    const int vb0 = (int)(uintptr_t)V_lds + v_rd_base(lane);
    struct { bf16x8 vs0, vs1, ks0, ks1; } sr_[SDEPTH];
    const unsigned goff = (unsigned)(sr * LDK + sc) * 2u, goff1 = goff + 32u * LDK * 2u;
#define KROW(j) ((j) < 4 ? a.ctx_row0 + 64 * (j) : a.lat_row0 + 64 * ((j) - 4))
#define SLOAD(i, j) do { const size_t _kb = (size_t)KROW(j) * (LDK * 2); const char* _vp = (const char*)a.Vb + _kb; const char* _kp = (const char*)a.Kb + _kb; \
    sr_[i].vs0 = *(const bf16x8*)(_vp + goff); sr_[i].vs1 = *(const bf16x8*)(_vp + goff1); \
    sr_[i].ks0 = *(const bf16x8*)(_kp + goff); sr_[i].ks1 = *(const bf16x8*)(_kp + goff1); } while (0)
#define SWRITE(b, i) do { *(bf16x8*)(V_lds + (b) * SHM_V + vst0) = sr_[i].vs0;          \
    *(bf16x8*)(V_lds + (b) * SHM_V + vst1) = sr_[i].vs1; int kc = sc * 2;               \
    *(bf16x8*)(K_lds + (b) * SHM_K + KSWZ(sr, kc)) = sr_[i].ks0;                       \
    *(bf16x8*)(K_lds + (b) * SHM_K + KSWZ(32 + sr, kc)) = sr_[i].ks1; } while (0)
#define SWAIT() do { if constexpr (SDEPTH == 2) asm volatile("s_waitcnt vmcnt(4)" ::: "memory"); else asm volatile("s_waitcnt vmcnt(0)" ::: "memory"); } while (0)
#define RESC(al) do { if (__any((al) < 1.f)) { if (hi == 0) al_l[r32] = (al); asm volatile("s_waitcnt lgkmcnt(0)" ::: "memory"); \
    _Pragma("unroll") for (int d = 0; d < 4; ++d) _Pragma("unroll") for (int r = 0; r < 16; ++r) o[d][r] *= al_l[crow(r, hi)]; } } while (0)
    f32x16 pA0, pA1, pB0, pB1; float mnA, mnB, alA, alB; bf16x8 pa0, pa1, pa2, pa3; const int NT = a.NT;
    constexpr int SE = 0, SO = SDEPTH - 1;
    SLOAD(SE, 0); asm volatile("s_waitcnt vmcnt(0)" ::: "memory"); SWRITE(0, SE); __syncthreads();
    qkt(pA0, pA1, K_lds, qr, r32, hi); partialSM(pA0, pA1, m_reg, mnA, alA);
    SLOAD(SO, 1); if constexpr (SDEPTH == 2) { if (2 < NT) SLOAD(SE, 2); }
    SWAIT(); SWRITE(1, SO); __syncthreads();
    bool dA = false, dB = false;
    for (int j = 1; j + 1 < NT; j += 2) {
        dB = tile_dead<MODE>(j, a, wid);
        SBAR(); if (!dB) qkt(pB0, pB1, K_lds + SHM_K, qr, r32, hi);
        if (!dA) finishSM(pA0, pA1, alA, l_reg, pa0, pa1, pa2, pa3); SBAR();
        SLOAD(SO, j + SDEPTH); SBAR();
        if (!dA) pv_d0(o, vb0, pa0, pa1, pa2, pa3);
        if (!dB) { apply_mask<MODE>(pB0, pB1, j, a, wid, r32, hi, btab); partialSM(pB0, pB1, m_reg, mnB, alB); } else alB = 1.f;
        __syncthreads(); SWAIT(); SWRITE(0, SE);
        RESC(alB); __syncthreads();
        dA = tile_dead<MODE>(j + 1, a, wid);
        SBAR(); if (!dA) qkt(pA0, pA1, K_lds, qr, r32, hi);
        if (!dB) finishSM(pB0, pB1, alB, l_reg, pa0, pa1, pa2, pa3); SBAR();
        if (SDEPTH == 1 || j + 3 < NT) SLOAD(SE, j + 1 + SDEPTH); SBAR();
        if (!dB) pv_d0(o, vb0 + (int)SHM_V, pa0, pa1, pa2, pa3);
        if (!dA) { apply_mask<MODE>(pA0, pA1, j + 1, a, wid, r32, hi, btab); partialSM(pA0, pA1, m_reg, mnA, alA); } else alA = 1.f;
        __syncthreads(); SWAIT(); SWRITE(1, SO);
        RESC(alA); __syncthreads();
    }
    dB = tile_dead<MODE>(NT - 1, a, wid);
    SBAR(); if (!dB) qkt(pB0, pB1, K_lds + SHM_K, qr, r32, hi);
    if (!dA) finishSM(pA0, pA1, alA, l_reg, pa0, pa1, pa2, pa3); SBAR();
    if (!dA) pv_d0(o, vb0, pa0, pa1, pa2, pa3);
    if (!dB) { apply_mask<MODE>(pB0, pB1, NT - 1, a, wid, r32, hi, btab); partialSM(pB0, pB1, m_reg, mnB, alB); } else alB = 1.f;
    __syncthreads(); RESC(alB);
    if (!dB) { finishSM(pB0, pB1, alB, l_reg, pa0, pa1, pa2, pa3); SBAR();
        pv_d0(o, vb0 + (int)SHM_V, pa0, pa1, pa2, pa3); }
    l_reg += __builtin_amdgcn_exp2f(a.sink_l2 - m_reg * (SCALE * 1.4426950408889634f));
    if (hi == 0) li_l[r32] = l_reg; asm volatile("s_waitcnt lgkmcnt(0)" ::: "memory");
    float rli[16];
#pragma unroll
    for (int r = 0; r < 16; ++r) rli[r] = __builtin_amdgcn_rcpf(li_l[crow(r, hi)]);
    const int odd = lane & 1;
    char* Ow = (char*)(a.Ob + (long)(wid * QBLK + 4 * hi + odd) * LDO + (r32 & ~1));
#pragma unroll
    for (int r = 0; r < 16; r += 2) {
#pragma unroll
        for (int d0 = 0; d0 < 4; ++d0) { const float va = o[d0][r] * rli[r], vb = o[d0][r + 1] * rli[r + 1];
            const float recv = xor_swz<1>(odd ? va : vb);
            const unsigned w = odd ? cvt_pk_bf16(recv, vb) : cvt_pk_bf16(va, recv);
            *(unsigned*)(Ow + ((r & 3) + 8 * (r >> 2)) * (LDO * 2) + d0 * 64) = w; } }
#undef KROW
#undef SLOAD
#undef SWRITE
#undef SWAIT
#undef RESC
}
}

__device__ __forceinline__ const float* xrow_c(const Params& p, int row, bool from_input) { return row < MLAT ? (from_input ? p.x : p.out) + (size_t)row * DM : (const float*)(p.ws + WS_XC) + (size_t)(row - MLAT) * DM; }
__device__ __forceinline__ int row_set(int row) { return row < MLAT ? (row >> 12) : 4; }

__device__ __forceinline__ void convert_tile(const float* __restrict__ W, bf16_t* __restrict__ WT, int K, int N, int kt, int nt, unsigned* l32, int nout0) {
    const int tid = opaque_tid(), n4 = tid & 15, kp = tid >> 4;
    const int k0 = kt * 256, n0 = nt * 64;
    __syncthreads();
#pragma unroll
    for (int it = 0; it < 4; ++it) {
        const int k = k0 + it * 64 + kp * 2;
        const f32x4 a = *(const f32x4*)(W + (size_t)k * N + n0 + n4 * 4), b = *(const f32x4*)(W + (size_t)(k + 1) * N + n0 + n4 * 4);
#pragma unroll
        for (int j = 0; j < 4; ++j) l32[(n4 * 4 + j) * 132 + it * 32 + kp] = cvt_pk_bf16(a[j], b[j]);
    }
    __syncthreads();
    const int n = tid >> 3, kc = tid & 7;
    const u32x4* src = (const u32x4*)(l32 + n * 132 + kc * 16);
    u32x4* dst = (u32x4*)(WT + (size_t)(nout0 + n) * K + k0 + kc * 32);
#pragma unroll
    for (int q = 0; q < 4; ++q) dst[q] = src[q];
}
__device__ void convert_weights(const Params& p, int l, unsigned char* lds, int mask) {
    bf16_t* WT = (bf16_t*)(p.ws + WS_WT);
    constexpr int T0 = 1280, T1 = T0 + 256, T2 = T1 + 256, T3 = T2 + 1408, T4 = T3 + 704;
    const int c0 = (mask & 1) ? 1280 : 0, c1 = (mask & 2) ? 256 : 0, c2 = (mask & 4) ? 256 : 0, c3 = (mask & 8) ? 1408 : 0, c4 = (mask & 16) ? 704 : 0;
    const int total = c0 + c1 + c2 + c3 + c4;
    const bool skew = (l == 0 && mask == 31 && gridDim.x == 256);
    const int id0 = skew ? (blockIdx.x < 192 ? (int)blockIdx.x : 2688 + (int)blockIdx.x - 192) : (int)blockIdx.x;
    const int idstep = skew ? (blockIdx.x < 192 ? 192 : 64) : (int)gridDim.x;
    const int idend = skew ? (blockIdx.x < 192 ? 2688 : T4) : total;
    for (int cid = id0; cid < idend; cid += idstep) {
        int r = cid, id;
        if (r < c0) id = r; else { r -= c0; if (r < c1) id = T0 + r; else { r -= c1; if (r < c2) id = T1 + r; else { r -= c2; if (r < c3) id = T2 + r; else id = T3 + (r - c3); } } }
        const float* W; bf16_t* O; int K, N, t;
        if (id < T0) { W = p.w_in + (size_t)l * DM * NQ; O = WT + WT_IN; K = DM; N = NQ; t = id; }
        else if (id < T1) { W = p.w_branch + (size_t)l * DM * DM; O = WT + WT_BR; K = DM; N = DM; t = id - T0; }
        else if (id < T2) { W = p.w_out + (size_t)l * DM * DM; O = WT + WT_OUT; K = DM; N = DM; t = id - T1; }
        else if (id < T3) { W = p.w_up + (size_t)l * DM * NUP; O = WT + WT_UP; K = DM; N = NUP; t = id - T2; }
        else { W = p.w_down + (size_t)l * DFF * DM; O = WT + WT_DOWN; K = DFF; N = DM; t = id - T3; }
        const int nnt = N / 64, n0 = (t % nnt) * 64;
        int nout0 = n0;
        if (id >= T2 && id < T3) { const int mm = n0 < DFF ? n0 : n0 - DFF; nout0 = (mm >> 7) * 256 + (n0 < DFF ? 0 : 128) + (mm & 127); }
        convert_tile(W, O, K, N, t / nnt, t % nnt, (unsigned*)lds, nout0);
    }
    __syncthreads();
}

__device__ void quant_rows(const bf16_t* __restrict__ Wt, unsigned char* __restrict__ W8, float* __restrict__ cs, int nrows) {
    const int tid = opaque_tid(), wid = tid >> 6, lane = tid & 63;
    for (int row = blockIdx.x * 8 + wid; row < nrows; row += gridDim.x * 8) {
        const u32x4* src = (const u32x4*)(Wt + (size_t)row * DM) + lane * 4;
        u32x4 w[4]; float f[32]; float mx = 0.f;
#pragma unroll
        for (int q = 0; q < 4; ++q) w[q] = src[q];
#pragma unroll
        for (int q = 0; q < 4; ++q)
#pragma unroll
            for (int c = 0; c < 4; ++c) { f[q * 8 + 2 * c] = bf_lo(w[q][c]); f[q * 8 + 2 * c + 1] = bf_hi(w[q][c]); }
#pragma unroll
        for (int i = 0; i < 32; ++i) mx = fmaxf(mx, fabsf(f[i]));
        mx = wave_max(mx);
        const float sc = mx > 0.f ? mx * (1.f / 127.f) : 1.f, inv = 1.f / sc;
        u32x4 o0, o1;
#pragma unroll
        for (int c = 0; c < 4; ++c) { o0[c] = pack_i8x4(f[4 * c] * inv, f[4 * c + 1] * inv, f[4 * c + 2] * inv, f[4 * c + 3] * inv);
                                      o1[c] = pack_i8x4(f[16 + 4 * c] * inv, f[17 + 4 * c] * inv, f[18 + 4 * c] * inv, f[19 + 4 * c] * inv); }
        u32x4* dst = (u32x4*)(W8 + (size_t)row * DM) + lane * 2;
        dst[0] = o0; dst[1] = o1;
        if (lane == 0) cs[row] = sc;
    }
}
__device__ void quant_weights(const Params& p, bool up) {
    const bf16_t* WT = (const bf16_t*)(p.ws + WS_WT);
    quant_rows(WT + WT_IN, p.ws + WS_W8IN, (float*)(p.ws + WS_CSIN), NQ);
    if (up) quant_rows(WT + WT_UP, p.ws + WS_W8UP, (float*)(p.ws + WS_CSUP), NUP);
}
__device__ void mod_phase(const Params& p, unsigned char* lds) {
    const int tid = opaque_tid();
    if ((int)blockIdx.x >= 192) return;
    float* sc = (float*)lds;
    float* red = (float*)(lds + 5 * DM * 4);
    __syncthreads();
    for (int i = tid; i < 5 * DM; i += NTHREADS) { const int s = i / DM, k = i % DM; const float v = s < 4 ? p.c[s * DM + k] : p.c_ctx[k]; sc[i] = v / (1.f + __expf(-v)); }
    __syncthreads();
    float* modv = (float*)(p.ws + WS_MOD);
    for (int it = blockIdx.x; it < 192; it += gridDim.x) {
        const int l = it / 96, cg0 = (it % 96) * 128;
        const int c4 = tid & 31, ks = tid >> 5;
        const float* W = p.w_ada + (size_t)l * DM * 6 * DM + cg0 + c4 * 4;
        f32x4 acc[5];
#pragma unroll
        for (int s = 0; s < 5; ++s) acc[s] = (f32x4){0.f, 0.f, 0.f, 0.f};
#pragma unroll 8
        for (int kk = 0; kk < 128; ++kk) { const int k = ks * 128 + kk; const f32x4 w = *(const f32x4*)(W + (size_t)k * 6 * DM);
#pragma unroll
            for (int s = 0; s < 5; ++s) acc[s] += sc[s * DM + k] * w; }
#pragma unroll
        for (int s = 0; s < 5; ++s) *(f32x4*)(red + (ks * 5 + s) * 128 + c4 * 4) = acc[s];
        __syncthreads();
        for (int i = tid; i < 5 * 128; i += NTHREADS) { const int s = i / 128, cc = i % 128; float v = p.b_ada[(size_t)l * 6 * DM + cg0 + cc];
#pragma unroll
            for (int k2 = 0; k2 < 16; ++k2) v += red[(k2 * 5 + s) * 128 + cc];
            modv[((size_t)l * 5 + s) * 6 * DM + cg0 + cc] = v; }
        __syncthreads();
    }
}

__device__ void phase_init(const Params& p, unsigned char* lds) {
    { const int tid = opaque_tid(); const f32x4* s4 = (const f32x4*)p.ctx; f32x4* d4 = (f32x4*)(p.ws + WS_XC); const long n4 = (long)MCTX * DM / 4;
      for (long i = (long)blockIdx.x * NTHREADS + tid; i < n4; i += (long)gridDim.x * NTHREADS) d4[i] = s4[i]; }
#ifdef PROBE_CONV2
    for (int rep = 0; rep < 2; ++rep) { mod_phase(p, lds); __syncthreads(); convert_weights(p, 0, lds, 31); }
#else
    mod_phase(p, lds);
    convert_weights(p, 0, lds, 31);
#endif
}

__device__ void phase_norm(const Params& p, int l, int which, int mrows, bf16_t* H, bool fold, bool q8) {
    const int tid = opaque_tid(), wid = tid >> 6, lane = tid & 63;
    const float* nw = (which ? p.norm2 : p.norm1) + (size_t)l * DM;
    const float* modl = (const float*)(p.ws + WS_MOD) + (size_t)l * 5 * 6 * DM;
    const bool from_in = (l == 0 && which == 0);
    const int stride = gridDim.x * 8;
    int row = blockIdx.x * 8 + wid;
    f32x4 v[8], vn[8];
    if (row < mrows) { const f32x4* xp = (const f32x4*)xrow_c(p, row, from_in);
#pragma unroll
        for (int i = 0; i < 8; ++i) v[i] = xp[i * 64 + lane]; }
    while (row < mrows) {
        const int nrow = row + stride;
        if (nrow < mrows) { const f32x4* xq = (const f32x4*)xrow_c(p, nrow, from_in);
#pragma unroll
            for (int i = 0; i < 8; ++i) vn[i] = xq[i * 64 + lane]; }
        const float* shift = modl + (size_t)row_set(row) * 6 * DM + (which ? 3 : 0) * DM; const float* scale = shift + DM;
        float ss = 0.f;
        if (fold && row >= MLAT) {
            const f32x4* pp = (const f32x4*)(p.ws + WS_PART) + (size_t)(row - MLAT) * (DM / 4);
#pragma unroll
            for (int s2 = 0; s2 < 8; ++s2)
#pragma unroll
                for (int i = 0; i < 8; ++i) v[i] += pp[(size_t)s2 * MCTX * (DM / 4) + i * 64 + lane];
            f32x4* xw = (f32x4*)(p.ws + WS_XC) + (size_t)(row - MLAT) * (DM / 4);
#pragma unroll
            for (int i = 0; i < 8; ++i) xw[i * 64 + lane] = v[i];
        }
#pragma unroll
        for (int i = 0; i < 8; ++i) ss += v[i][0] * v[i][0] + v[i][1] * v[i][1] + v[i][2] * v[i][2] + v[i][3] * v[i][3];
        ss = wave_sum(ss);
        const float rstd = rsqrtf(ss * (1.f / DM) + EPS);
        if (q8) {
            float mx = 0.f;
#pragma unroll
            for (int i = 0; i < 8; ++i) { const int col = (i * 64 + lane) * 4;
                const f32x4 g = *(const f32x4*)(nw + col), sh = *(const f32x4*)(shift + col), scv = *(const f32x4*)(scale + col);
                f32x4 y = v[i] * rstd * g; y = y * (1.f + scv) + sh; v[i] = y;
                mx = fmaxf(mx, fmaxf(fmaxf(fabsf(y[0]), fabsf(y[1])), fmaxf(fabsf(y[2]), fabsf(y[3])))); }
            mx = wave_max(mx);
            const float sc = mx > 0.f ? mx * (1.f / 127.f) : 1.f, inv = 1.f / sc;
            unsigned* hq = (unsigned*)((unsigned char*)H + (size_t)row * DM);
#pragma unroll
            for (int i = 0; i < 8; ++i) hq[i * 64 + lane] = pack_i8x4(v[i][0] * inv, v[i][1] * inv, v[i][2] * inv, v[i][3] * inv);
            if (lane == 0) ((float*)(p.ws + WS_RS))[row] = sc;
        } else {
#pragma unroll
        for (int i = 0; i < 8; ++i) { const int col = (i * 64 + lane) * 4;
            const f32x4 g = *(const f32x4*)(nw + col), sh = *(const f32x4*)(shift + col), scv = *(const f32x4*)(scale + col);
            f32x4 y = v[i] * rstd * g; y = y * (1.f + scv) + sh;
            u32x2 w; w.x = cvt_pk_bf16(y[0], y[1]); w.y = cvt_pk_bf16(y[2], y[3]);
            *(u32x2*)(H + (size_t)row * DM + col) = w; }
        }
#pragma unroll
        for (int i = 0; i < 8; ++i) v[i] = vn[i];
        row = nrow;
    }
}
__device__ void phase_final(const Params& p) {
    const int tid = opaque_tid(), wid = tid >> 6, lane = tid & 63;
    const int stride = gridDim.x * 8;
    int row = blockIdx.x * 8 + wid;
    f32x4 v[8], vn[8];
    if (row < MLAT) { const f32x4* xp = (const f32x4*)(p.out + (size_t)row * DM);
#pragma unroll
        for (int i = 0; i < 8; ++i) v[i] = xp[i * 64 + lane]; }
    while (row < MLAT) {
        const int nrow = row + stride;
        if (nrow < MLAT) { const f32x4* xq = (const f32x4*)(p.out + (size_t)nrow * DM);
#pragma unroll
            for (int i = 0; i < 8; ++i) vn[i] = xq[i * 64 + lane]; }
        f32x4* xp = (f32x4*)(p.out + (size_t)row * DM);
        float ss = 0.f;
#pragma unroll
        for (int i = 0; i < 8; ++i) ss += v[i][0] * v[i][0] + v[i][1] * v[i][1] + v[i][2] * v[i][2] + v[i][3] * v[i][3];
        ss = wave_sum(ss);
        const float rstd = rsqrtf(ss * (1.f / DM) + EPS);
#pragma unroll
        for (int i = 0; i < 8; ++i) { const int col = (i * 64 + lane) * 4; const f32x4 g = *(const f32x4*)(p.final_norm + col); xp[i * 64 + lane] = v[i] * rstd * g; }
#pragma unroll
        for (int i = 0; i < 8; ++i) v[i] = vn[i];
        row = nrow;
    }
}

__device__ void phase_rope(const Params& p, int l, unsigned char* lds) {
    const int tid = opaque_tid();
    float2* tab = (float2*)lds;
    __syncthreads();
    for (int i = tid; i < 2048; i += NTHREADS) { const int pos = i >> 5, j = i & 31; const float inv = exp2f(-(float)j * (13.287712379549449f / 32.f)); float s, c; sincosf((float)pos * inv, &s, &c); tab[i] = make_float2(c, s); }
    __syncthreads();
    bf16_t* QKVG = (bf16_t*)(p.ws + WS_R1);
    const int sub = tid & 15, grp = tid >> 4;
    const float* qn = p.qnorm_c + l * 128; const float* kn = p.knorm_c + l * 128;
    const long nlat = (long)MLAT * 4, total = nlat + (long)MCTX * 2;
    const long stride = (long)gridDim.x * 32;
    for (long id0 = (long)blockIdx.x * 32 + grp; id0 < total; id0 += 4 * stride) {
        bf16_t* ptr[4]; u32x4 w[4]; int rowv[4], slotv[4];
#pragma unroll
        for (int u = 0; u < 4; ++u) {
            const long id = id0 + u * stride; const bool ok = id < total; const long idc = ok ? id : id0;
            int row, slot; if (idc < nlat) { row = (int)(idc >> 2); const int s4 = (int)(idc & 3); slot = s4 < 2 ? 6 + s4 : 12 + s4; } else { const long j = idc - nlat; row = MLAT + (int)(j >> 1); slot = 14 + (int)(j & 1); }
            const int col = slot < 6 ? QA + slot * 128 : (slot < 8 ? KA + (slot - 6) * 128 : (slot < 14 ? QC + (slot - 8) * 128 : KC + (slot - 14) * 128));
            ptr[u] = QKVG + (size_t)row * QP + col + sub * 8; rowv[u] = row; slotv[u] = ok ? slot : -1;
            w[u] = *(const u32x4*)ptr[u];
        }
#pragma unroll
        for (int u = 0; u < 4; ++u) {
            const int row = rowv[u], slot = slotv[u];
            const bool lat = row < MLAT, isC = slot >= 8;
            float v[8];
#pragma unroll
            for (int q = 0; q < 4; ++q) { v[2 * q] = bf_lo(w[u][q]); v[2 * q + 1] = bf_hi(w[u][q]); }
            if (isC) {
                const float* gw = slot < 14 ? qn : kn;
                float ss = 0.f;
#pragma unroll
                for (int i = 0; i < 8; ++i) ss += v[i] * v[i];
                ss += xor_swz<1>(ss); ss += xor_swz<2>(ss); ss += xor_swz<4>(ss); ss += xor_swz<8>(ss);
                const float rstd = rsqrtf(ss * (1.f / 128.f) + EPS);
                const f32x4 g0 = *(const f32x4*)(gw + sub * 8), g1 = *(const f32x4*)(gw + sub * 8 + 4);
#pragma unroll
                for (int i = 0; i < 4; ++i) { v[i] = v[i] * rstd * g0[i]; v[4 + i] = v[4 + i] * rstd * g1[i]; }
            }
            float pv[8];
#pragma unroll
            for (int i = 0; i < 8; ++i) pv[i] = xor_swz<4>(v[i]);
            if (lat) {
                const int t = row & (SEQ - 1); const int pos = (sub & 8) ? (t & 63) : (t >> 6);
                const bool upper = (sub & 4) != 0; const int j0 = (sub & 3) * 8;
#pragma unroll
                for (int i = 0; i < 8; ++i) { const float2 cs = tab[pos * 32 + j0 + i]; v[i] = upper ? v[i] * cs.x + pv[i] * cs.y : v[i] * cs.x - pv[i] * cs.y; }
            }
            if (slot >= 0) { u32x4 o; o.x = cvt_pk_bf16(v[0], v[1]); o.y = cvt_pk_bf16(v[2], v[3]); o.z = cvt_pk_bf16(v[4], v[5]); o.w = cvt_pk_bf16(v[6], v[7]);
                *(u32x4*)ptr[u] = o; }
        }
    }
}

__device__ void phase_glufix(const Params& p, int l, int mrows) {
    bf16_t* Gb = (bf16_t*)(p.ws + WS_R1);
    const float* ES = (const float*)(p.ws + WS_EDGE); const float* EA = ES + (size_t)EDGE_N; const float* EU = EA + (size_t)EDGE_N;
    const float* cw = p.conv_w + (size_t)l * 3 * DFF;
    constexpr int NC4 = DFF / 4;
    const int tid = opaque_tid();
    const long total = (long)(mrows / 64) * 2 * NC4;
    for (long id = (long)blockIdx.x * NTHREADS + tid; id < total; id += (long)gridDim.x * NTHREADS) {
        const int c4 = (int)(id % NC4), be = (int)(id / NC4), blk = be >> 1, e = be & 1;
        const int sb = blk < MLAT / 64 ? (blk & 63) : ((blk - MLAT / 64) & 3), sl = blk < MLAT / 64 ? 63 : 3;
        if (e == 0 ? sb == 0 : sb == sl) continue;
        const int nb = e ? (blk + 1) * 2 : (blk - 1) * 2 + 1;
        const f32x4 s = *(const f32x4*)(ES + (size_t)be * DFF + 4 * c4), an = *(const f32x4*)(EA + (size_t)nb * DFF + 4 * c4), uu = *(const f32x4*)(EU + (size_t)be * DFF + 4 * c4);
        const f32x4 w = *(const f32x4*)(cw + (e ? 2 * DFF : 0) + 4 * c4);
        float g[4];
#pragma unroll
        for (int i = 0; i < 4; ++i) { const float v = s[i] + w[i] * an[i]; g[i] = v * __builtin_amdgcn_rcpf(1.f + __expf(-v)) * uu[i]; }
        u32x2 o; o.x = cvt_pk_bf16(g[0], g[1]); o.y = cvt_pk_bf16(g[2], g[3]);
        *(u32x2*)(Gb + (size_t)(blk * 64 + 63 * e) * DFF + 4 * c4) = o;
    }
}

__device__ void phase_attn(const Params& p, int l, unsigned char* lds, int ctr_off) {
    unsigned* ctr = (unsigned*)(p.ws + WS_CTL) + l + ctr_off;
    const int nitems = (l == DEPTH - 1) ? 1024 : 1088;
    volatile int* sh = (volatile int*)(lds + LDS_MISC);
    const bf16_t* QKVG = (const bf16_t*)(p.ws + WS_R1);
    bf16_t* O = (bf16_t*)(p.ws + WS_B + BUF1);
    float* btab = (float*)(lds + att::BTAB_OFF);
    constexpr float L2E = 1.4426950408889634f;
    { const int t0 = opaque_tid(); float2* rtab = (float2*)(lds + att::RTAB_OFF);
      __syncthreads();
      for (int i = t0; i < 2048; i += NTHREADS) { const int pos = i >> 5, j = i & 31; const float inv = exp2f(-(float)j * (13.287712379549449f / 32.f)); float s, c; sincosf((float)pos * inv, &s, &c); rtab[i] = make_float2(c, s); }
      __syncthreads(); }
    for (;;) {
        const int tid = opaque_tid();
        __syncthreads();
        if (tid == 0) sh[0] = (int)atomicAdd(ctr, 1u);
        __syncthreads();
        const int it = __builtin_amdgcn_readfirstlane(sh[0]);
        if (it >= nitems) break;
        att::Args a; a.sink_l2 = -1e30f; a.abase = 0; a.b_r0 = 0; a.b_rs0 = 0; a.qg = nullptr; a.q_rope = 0; a.q_t0 = 0;
        if (it < 768) {
            const bool isC = it < 384; const int i = isC ? it : it - 384;
            const int b = i / 96, r = i % 96, kvh = r / 48, r2 = r % 48, g = r2 >> 4, qt = r2 & 15, h = kvh * 3 + g;
            const int row0 = b * SEQ + qt * 256;
            a.ctx_row0 = MLAT + b * CTXL;
            if (isC) {
                a.Qb = QKVG + (size_t)row0 * QP + QC + h * 128; a.Kb = QKVG + KC + kvh * 128; a.Vb = QKVG + VC + kvh * 128; a.Ob = O + (size_t)row0 * DM + OC + h * 128;
                a.lat_row0 = b * SEQ; a.NT = 68; a.qg = p.qnorm_c + l * 128; a.q_rope = 1; a.q_t0 = qt * 256;
                att::attn_body<0>(a, (char*)lds);
            } else {
                const int q0 = qt * 256, ks = max(q0 - 128, 0), ke = min(q0 + 384, SEQ);
                a.Qb = QKVG + (size_t)row0 * QP + QA + h * 128; a.Kb = QKVG + KA + kvh * 128; a.Vb = QKVG + VA + kvh * 128; a.Ob = O + (size_t)row0 * DM + OA + h * 128;
                a.lat_row0 = b * SEQ + ks; a.NT = 4 + (ke - ks) / 64; a.abase = ks - q0; a.sink_l2 = p.sink_a[l * 6 + h] * L2E; a.q_rope = 1; a.q_t0 = q0;
                att::attn_body<1>(a, (char*)lds);
            }
        } else if (it < 1024) {
            const int i = it - 768, b = i >> 6, h = (i & 63) >> 4, qt = i & 15, r0 = qt * 4;
            const int rs0 = min(max(r0 - 4, 0), 56), rend = min(max(r0 - 1, 0), 56) + 8;
            const int row0 = b * SEQ + qt * 256;
            for (int k = tid; k < 15 * 31; k += NTHREADS) btab[k] = p.rpb_b[((size_t)l * 4 + h) * 465 + k] * 11.313708498984761f;
            a.ctx_row0 = MLAT + b * CTXL;
            a.Qb = QKVG + (size_t)row0 * QP + QB + h * 128; a.Kb = QKVG + KB + h * 128; a.Vb = QKVG + VB + h * 128; a.Ob = O + (size_t)row0 * DM + OB + h * 128;
            a.lat_row0 = b * SEQ + rs0 * 64; a.NT = (4 + (rend - rs0) + 1) & ~1; a.b_r0 = r0; a.b_rs0 = rs0;
            att::attn_body<2>(a, (char*)lds);
        } else {
            const int i = it - 1024, b = i >> 4, hs = i & 15;
            const int row0 = MLAT + b * CTXL;
            int qc, kc, vc, oc;
            if (hs < 6) { const int h = hs, kvh = h / 3; qc = QA + h * 128; kc = KA + kvh * 128; vc = VA + kvh * 128; oc = OA + h * 128; a.sink_l2 = p.sink_a[l * 6 + h] * L2E; }
            else if (hs < 10) { const int h = hs - 6; qc = QB + h * 128; kc = KB + h * 128; vc = VB + h * 128; oc = OB + h * 128; }
            else { const int h = hs - 10, kvh = h / 3; qc = QC + h * 128; kc = KC + kvh * 128; vc = VC + kvh * 128; oc = OC + h * 128; a.qg = p.qnorm_c + l * 128; }
            a.ctx_row0 = row0; a.lat_row0 = 0; a.NT = 4;
            a.Qb = QKVG + (size_t)row0 * QP + qc; a.Kb = QKVG + kc; a.Vb = QKVG + vc; a.Ob = O + (size_t)row0 * DM + oc;
            att::attn_body<0>(a, (char*)lds);
        }
    }
}

#define XB_TMO      128
#define XB_XCNT(j)  (256  + 64 * (j))
#define XB_XSUB(j)  (1280 + 64 * (j))
#define XB_XGEN(j)  (2304 + 64 * (j))
#define XB_TOP      3328
#define XB_TOPGEN   3392
#define XCD_BAR_WORDS 3456
#define XB_SPIN_CAP (1u << 20)
__device__ __forceinline__ unsigned xb_ld(unsigned* p)              { return __hip_atomic_load(p, __ATOMIC_RELAXED, __HIP_MEMORY_SCOPE_AGENT); }
__device__ __forceinline__ unsigned xb_add(unsigned* p, unsigned v) { return __hip_atomic_fetch_add(p, v, __ATOMIC_RELAXED, __HIP_MEMORY_SCOPE_AGENT); }
__device__ __forceinline__ unsigned xb_xcc_id() { return (unsigned)__builtin_amdgcn_s_getreg((3 << 11) | 20) & 0xFu; }
#define XB_SPIN(cond, bar) do { unsigned _sp = 0; while (cond) { __builtin_amdgcn_s_sleep(1); \
    if ((++_sp & 255u) == 0u) { if (xb_ld(&(bar)[XB_TMO])) break; if (_sp > XB_SPIN_CAP) { atomicAdd(&(bar)[XB_TMO], 1u); break; } } } } while (0)
struct XcdBarrier { unsigned* bar; unsigned x; volatile LAS unsigned* st; };
__device__ __forceinline__ XcdBarrier xcd_barrier_post(unsigned* bar, volatile LAS unsigned* st) {
    XcdBarrier b; b.bar = bar; b.x = xb_xcc_id(); b.st = st;
    if (threadIdx.x == 0) (void)xb_add(&bar[XB_XCNT(b.x)], 1u);
    return b;
}
__device__ __forceinline__ void xcd_barrier_complete(unsigned* bar, unsigned x, unsigned& nloc, unsigned& nx) {
    const unsigned G = gridDim.x * gridDim.y * gridDim.z;
    unsigned sum, cnt, mine, sp = 0u;
    for (;;) {
        sum = 0u; cnt = 0u; mine = 0u;
#pragma unroll
        for (unsigned j = 0; j < 16; ++j) { const unsigned c = xb_ld(&bar[XB_XCNT(j)]); sum += c; cnt += (c > 0u) ? 1u : 0u; mine = (j == x) ? c : mine; }
        if (sum == G) break;
        __builtin_amdgcn_s_sleep(1);
        if ((++sp & 255u) == 0u) { if (xb_ld(&bar[XB_TMO])) break; if (sp > XB_SPIN_CAP) { atomicAdd(&bar[XB_TMO], 1u); break; } }
    }
    nloc = mine > 0u ? mine : 1u; nx = cnt > 0u ? cnt : 1u;
}
__device__ __forceinline__ void xcd_barrier(const XcdBarrier& b) {
    asm volatile("s_waitcnt vmcnt(0)" ::: "memory");
    __syncthreads();
    if (threadIdx.x == 0) {
        unsigned* bar = b.bar;
        __builtin_amdgcn_s_waitcnt(0);
        unsigned nloc = b.st[0], nx = b.st[1];
        if (nloc == 0u) { xcd_barrier_complete(bar, b.x, nloc, nx); b.st[0] = nloc; b.st[1] = nx; }
        const unsigned old = xb_add(&bar[XB_XSUB(b.x)], 1u);
        const unsigned gen = old / nloc;
        if (old + 1u == (gen + 1u) * nloc) {
            __builtin_amdgcn_fence(__ATOMIC_RELEASE, "agent");
            asm volatile("s_waitcnt vmcnt(0)" ::: "memory");
            const unsigned og = xb_add(&bar[XB_TOP], 1u);
            const unsigned tg = og / nx;
            if (og + 1u == (tg + 1u) * nx) xb_add(&bar[XB_TOPGEN], 1u);
            else XB_SPIN(xb_ld(&bar[XB_TOPGEN]) == tg, bar);
            __builtin_amdgcn_fence(__ATOMIC_ACQUIRE, "agent");
            xb_add(&bar[XB_XGEN(b.x)], 1u);
            asm volatile("s_waitcnt vmcnt(0)" ::: "memory");
        } else {
            XB_SPIN(xb_ld(&bar[XB_XGEN(b.x)]) == gen, bar);
            __builtin_amdgcn_fence(__ATOMIC_ACQUIRE, "agent");
            asm volatile("s_waitcnt vmcnt(0)" ::: "memory");
        }
    }
    __syncthreads();
}

constexpr int NPHASES = 2 + 10 * DEPTH;

__device__ __forceinline__ void run_phase(const Params& p, int ph, unsigned char* shm) {
    LAS unsigned char* lds3 = (LAS unsigned char*)shm;
    bf16_t* WT = (bf16_t*)(p.ws + WS_WT);
    bf16_t* R1 = (bf16_t*)(p.ws + WS_R1);
    bf16_t* B1 = (bf16_t*)(p.ws + WS_B); bf16_t* B2 = (bf16_t*)(p.ws + WS_B + BUF1); bf16_t* B3 = (bf16_t*)(p.ws + WS_B + 2 * BUF1);
    float* xc = (float*)(p.ws + WS_XC);
    if (ph == 0) { phase_init(p, shm); return; }
    if (ph == NPHASES - 1) { phase_final(p); return; }
    const int l = (ph - 1) / 10, s = (ph - 1) % 10;
    const bool lastl = (l == DEPTH - 1);
    const int mrows = lastl ? MLAT : MTOT;
    const float* modl = (const float*)(p.ws + WS_MOD) + (size_t)l * 5 * 6 * DM;
    pg8::StaticOrder S;
    const bool upq = ((UP_I8_MASK >> l) & 1) != 0, upq_next = !lastl && ((UP_I8_MASK >> (l + 1)) & 1) != 0;
    switch (s) {
    case 0:
        if (l > 0) convert_weights(p, l, shm, upq ? (2 | 4 | 16) : (2 | 4 | 8 | 16));
        else quant_weights(p, upq);
        phase_norm(p, l, 0, MTOT, B1, l > 0, true);
        break;
    case 7: {
        float* ES = (float*)(p.ws + WS_EDGE);
        if (upq) {
            pg8::Gemm g{B1, p.ws + WS_W8UP, mrows, NUP, DM};
            pg8::EpiGLU<true> E{R1, p.conv_w + (size_t)l * 3 * DFF, p.conv_b + (size_t)l * DFF, ES, ES + EDGE_N, ES + 2 * EDGE_N, 0, (const float*)(p.ws + WS_RS), (const float*)(p.ws + WS_CSUP)};
            S.init(g.M, g.N, g.PB, gridDim.x, blockIdx.x, 0);
            pg8::gemm_phase<pg8::EpiGLU<true>, true>(lds3, g, S, E);
        } else {
            pg8::Gemm g{B1, WT + WT_UP, mrows, NUP, DM * 2};
            pg8::EpiGLU<false> E{R1, p.conv_w + (size_t)l * 3 * DFF, p.conv_b + (size_t)l * DFF, ES, ES + EDGE_N, ES + 2 * EDGE_N, 0, nullptr, nullptr};
            S.init(g.M, g.N, g.PB, gridDim.x, blockIdx.x, 0);
            pg8::gemm_phase<pg8::EpiGLU<false>, false>(lds3, g, S, E);
        }
    } break;
    case 1: {
        pg8::Gemm g{B1, p.ws + WS_W8IN, MTOT, NQ, DM};
        pg8::EpiStoreQ E{R1, QP, (const float*)(p.ws + WS_RS), (const float*)(p.ws + WS_CSIN), p.ws + WS_GATES};
        S.init(g.M, g.N, g.PB, gridDim.x, blockIdx.x, 0);
        pg8::gemm_phase<pg8::EpiStoreQ, true>(lds3, g, S, E);
    } break;
    case 2:
        if (!lastl) convert_weights(p, l + 1, shm, upq_next ? (1 | 8) : 1);
        phase_rope(p, l, shm); break;
    case 3:
#ifdef PROBE_ATT2
        for (int rep = 2; rep >= 0; rep -= 2) { phase_attn(p, l, shm, rep); __syncthreads(); }
#else
        phase_attn(p, l, shm, 0);
#endif
        break;
    case 4: {
        pg8::Gemm g{B2, WT + WT_BR, mrows, DM, DM * 2}; pg8::EpiBranch E{p.ws + WS_GATES, B3, 0};
        S.init(g.M, g.N, g.PB, gridDim.x, blockIdx.x, 0);
#ifdef PROBE_GEMM2
        E.dry = 1; pg8::gemm_phase<pg8::EpiBranch>(lds3, g, S, E); E.dry = 0; __syncthreads();
#endif
        pg8::gemm_phase<pg8::EpiBranch>(lds3, g, S, E);
    } break;
    case 5: case 9: {
        pg8::Gemm g; pg8::EpiResid E;
        if (s == 5) { g = pg8::Gemm{B3, WT + WT_OUT, mrows, DM, DM * 2}; E = pg8::EpiResid{p.out, xc, l == 0 ? p.x : p.out, xc, modl + 2 * DM, (float*)(p.ws + WS_PART), 0}; }
        else { g = pg8::Gemm{R1, WT + WT_DOWN, mrows, DM, DFF * 2}; E = pg8::EpiResid{p.out, xc, p.out, xc, modl + 5 * DM, (float*)(p.ws + WS_PART), 0}; }
        S.init(g.M, g.N, g.PB, gridDim.x, blockIdx.x, lastl ? 0 : MCTX / 256);
#ifdef PROBE_GEMM2
        E.dry = 1; pg8::gemm_phase<pg8::EpiResid>(lds3, g, S, E); E.dry = 0; __syncthreads();
#endif
        pg8::gemm_phase<pg8::EpiResid>(lds3, g, S, E);
    } break;
    case 6: phase_norm(p, l, 1, mrows, B1, !lastl, upq); break;
    case 8:
        if (!lastl) quant_weights(p, upq_next);
        phase_glufix(p, l, mrows); break;
    }
}

__global__ void __launch_bounds__(NTHREADS, 2) mega(Params p) {
    extern __shared__ __attribute__((aligned(16))) unsigned char shm[];
    cg::grid_group grid = cg::this_grid();
    volatile LAS unsigned* st = (volatile LAS unsigned*)((LAS unsigned char*)shm + LDS_MISC + 64);
    if (threadIdx.x == 0) { st[0] = 0u; st[1] = 0u; }
    __syncthreads();
    XcdBarrier xb{};
    if (p.coop) xb = xcd_barrier_post((unsigned*)(p.ws + WS_BAR), st);
#ifdef PROBE_REPEAT_S
    bool again = false;
#endif
    for (int ph = p.ph_lo; ph < p.ph_hi; ++ph) {
        run_phase(p, ph, shm);
        if (p.coop && ph + 1 < p.ph_hi) {
            if (p.pad == 0x5eed) grid.sync();
            else xcd_barrier(xb);
        }
#ifdef PROBE_REPEAT_S
        if (ph >= 1 && ph < NPHASES - 1 && ((ph - 1) % 10) == PROBE_REPEAT_S && !again) { again = true; --ph; } else again = false;
#endif
    }
}

extern "C" void kernel_launch(void* const* d_in, const int* in_sizes, int n_in, void* d_out, int out_size, void* d_ws, size_t ws_size, hipStream_t stream) {
    static int grid = 0;
    if (grid == 0) {
        if (n_in != 20 || ws_size < WS_END) { fprintf(stderr, "kernel_launch: unexpected n_in %d / ws %zu (need %zu)\n", n_in, ws_size, (size_t)WS_END); grid = -1; return; }
        if (hipFuncSetAttribute((const void*)mega, hipFuncAttributeMaxDynamicSharedMemorySize, LDS_BYTES) != hipSuccess) { fprintf(stderr, "kernel_launch: hipFuncSetAttribute failed\n"); grid = -1; return; }
        int dev = 0, cus = 0, per_cu = 0;
        hipGetDevice(&dev); hipDeviceGetAttribute(&cus, hipDeviceAttributeMultiprocessorCount, dev);
        if (hipOccupancyMaxActiveBlocksPerMultiprocessor(&per_cu, (const void*)mega, NTHREADS, LDS_BYTES) != hipSuccess || per_cu < 1) { fprintf(stderr, "kernel_launch: occupancy query gave %d\n", per_cu); per_cu = 1; }
        (void)hipGetLastError();
        grid = cus;
    }
    if (grid < 0) return;
    if (hipMemsetAsync((char*)d_ws + WS_CTL, 0, WS_CTL_BYTES, stream) != hipSuccess) { fprintf(stderr, "kernel_launch: memset of the control words failed\n"); return; }
    Params p{};
    const float** f = (const float**)&p;
    for (int i = 0; i < 20; ++i) f[i] = (const float*)d_in[i];
    p.out = (float*)d_out; p.ws = (unsigned char*)d_ws;
#if MK_COOP
    p.ph_lo = 0; p.ph_hi = NPHASES; p.coop = 1; p.pad = 0;
    void* args[] = {&p};
    hipError_t e = hipLaunchCooperativeKernel((const void*)mega, dim3(grid), dim3(NTHREADS), args, LDS_BYTES, stream);
    if (e != hipSuccess) fprintf(stderr, "kernel_launch: cooperative launch failed: %s (grid %d)\n", hipGetErrorString(e), grid);
#else
    for (int ph = 0; ph < NPHASES; ++ph) {
        p.ph_lo = ph; p.ph_hi = ph + 1; p.coop = 0; p.pad = 0;
        hipLaunchKernelGGL(mega, dim3(grid), dim3(NTHREADS), LDS_BYTES, stream, p);
    }
#endif
}
```
